# Optimizing an MI355X kernel written in HIP

```python
import math
import jax, jax.numpy as jnp
from jax import lax
import numpy as np


D_MODEL = 2048
BATCH = 4
SEQ = 8192
DEPTH = 2

HEAD_DIM = 64
GROUP_HEADS = 8
GROUP_WIDTH = GROUP_HEADS * HEAD_DIM
N_GROUPS = 4
MIX_WIDTH = N_GROUPS * GROUP_WIDTH
D_FF = 4 * D_MODEL
Q_BLOCK = 128
EPS = 1e-6
NEG_INF = -1e30
BIG = 1e9

MLA_Q_RANK = 384
MLA_KV_RANK = 128
MLA_NOPE = 64
MLA_ROPE = 32
MLA_V = HEAD_DIM
ROPE_THETA = 10000.0

NSA_KV_HEADS = 2
NSA_KV_WIDTH = NSA_KV_HEADS * HEAD_DIM
NSA_CMP_LEN = 32
NSA_CMP_STRIDE = 16
NSA_SEL_LEN = 64
NSA_TOP_N = 8
NSA_WINDOW = 256

SWA_KV_HEADS = 2
SWA_KV_WIDTH = SWA_KV_HEADS * HEAD_DIM
SWA_WINDOW = 128

REL_BUCKETS = 32
REL_MAX_DIST = 128
REL_HEADS = 2 * GROUP_HEADS

IN_SPLITS = (
    MLA_Q_RANK, MLA_KV_RANK, MLA_ROPE,
    GROUP_WIDTH, GROUP_WIDTH, GROUP_WIDTH, GROUP_HEADS,
    GROUP_WIDTH, NSA_KV_WIDTH, NSA_KV_WIDTH, NSA_KV_WIDTH,
    NSA_KV_WIDTH, NSA_KV_WIDTH, NSA_KV_WIDTH, 3 * GROUP_HEADS,
    GROUP_WIDTH, SWA_KV_WIDTH, SWA_KV_WIDTH,
)
IN_COLS = sum(IN_SPLITS)

kernel_name = 'hybrid_mla_fox_nsa_swa_block'


def rmsnorm(x, g):
    xf = x.astype(jnp.float32)
    y = xf * lax.rsqrt(jnp.mean(xf * xf, axis=-1, keepdims=True) + EPS)
    return (y * g.astype(jnp.float32)).astype(x.dtype)


def split_heads(x, h):
    b, t, _ = x.shape
    return x.reshape(b, t, h, -1).transpose(0, 2, 1, 3)


def merge_heads(x):
    b, h, t, d = x.shape
    return x.transpose(0, 2, 1, 3).reshape(b, t, h * d)


def rope(x, pos):
    d = x.shape[-1]
    inv = ROPE_THETA ** (-jnp.arange(0, d, 2, dtype=jnp.float32) / d)
    ang = pos.astype(jnp.float32)[:, None] * inv[None, :]
    cos, sin = jnp.cos(ang), jnp.sin(ang)
    x1 = x[..., : d // 2].astype(jnp.float32)
    x2 = x[..., d // 2:].astype(jnp.float32)
    return jnp.concatenate([x1 * cos - x2 * sin, x1 * sin + x2 * cos], axis=-1).astype(x.dtype)


def t5_bucket(dist):
    max_exact = REL_BUCKETS // 2
    d = jnp.maximum(dist, 0)
    large = max_exact + (jnp.log(jnp.maximum(d, 1).astype(jnp.float32) / max_exact)
                         / math.log(REL_MAX_DIST / max_exact)
                         * (REL_BUCKETS - max_exact)).astype(jnp.int32)
    large = jnp.minimum(large, REL_BUCKETS - 1)
    return jnp.where(d < max_exact, d, large)


def dense_causal_attention(q, k, v, scale, fcum=None):
    b, h, t, dk = q.shape
    nb = t // Q_BLOCK
    kpos = jnp.arange(t)
    qb = q.reshape(b, h, nb, Q_BLOCK, dk).transpose(2, 0, 1, 3, 4)
    xs = (jnp.arange(nb), qb)
    if fcum is not None:
        xs = xs + (fcum.reshape(b, h, nb, Q_BLOCK).transpose(2, 0, 1, 3),)

    def one_block(args):
        i, qi = args[0], args[1]
        s = jnp.einsum('bhqd,bhkd->bhqk', qi, k, preferred_element_type=jnp.float32) * scale
        if fcum is not None:
            s = s + args[2][..., :, None] - fcum[:, :, None, :]
        qpos = i * Q_BLOCK + jnp.arange(Q_BLOCK)
        s = jnp.where(kpos[None, :] <= qpos[:, None], s, NEG_INF)
        p = jax.nn.softmax(s, axis=-1)
        return jnp.einsum('bhqk,bhkd->bhqd', p.astype(v.dtype), v)

    o = lax.map(one_block, xs)
    return o.transpose(1, 2, 0, 3, 4).reshape(b, h, t, v.shape[-1])


def banded_attention(q, k, v, window, tbl, sinks=None):
    b, g, r, t, d = q.shape
    nb, nw = t // Q_BLOCK, window // Q_BLOCK

    def blocks(a):
        ap = jnp.pad(a, ((0, 0), (0, 0), (window, 0), (0, 0))).reshape(b, g, nb + nw, Q_BLOCK, d)
        return jnp.concatenate([ap[:, :, i:i + nb] for i in range(nw + 1)], axis=3)

    kb, vb = blocks(k), blocks(v)
    qb = q.reshape(b, g, r, nb, Q_BLOCK, d)
    s = jnp.einsum('bgrnqd,bgnkd->bgrnqk', qb, kb, preferred_element_type=jnp.float32) * d ** -0.5
    kw = (nw + 1) * Q_BLOCK
    dist = (jnp.arange(Q_BLOCK)[:, None] + window) - jnp.arange(kw)[None, :]
    key_real = jnp.arange(nb)[:, None, None] * Q_BLOCK - window + jnp.arange(kw)[None, None, :]
    mask = (dist >= 0) & (dist < window) & (key_real >= 0)
    s = s + tbl[:, :, t5_bucket(dist)][:, :, None].astype(jnp.float32)
    s = jnp.where(mask, s, NEG_INF)
    if sinks is not None:
        sink = jnp.broadcast_to(sinks.astype(jnp.float32)[None, :, :, None, None, None], s.shape[:-1] + (1,))
        p = jax.nn.softmax(jnp.concatenate([s, sink], axis=-1), axis=-1)[..., :-1]
    else:
        p = jax.nn.softmax(s, axis=-1)
    o = jnp.einsum('bgrnqk,bgnkd->bgrnqd', p.astype(v.dtype), vb)
    return o.reshape(b, g, r, t, d)


def mla_mixer(c_q, c_kv, k_pe, q_norm, w_uq, kv_norm, w_ukv, pos):
    b, t, _ = c_q.shape
    q = split_heads(rmsnorm(c_q, q_norm) @ w_uq, GROUP_HEADS)
    q = jnp.concatenate([q[..., :MLA_NOPE], rope(q[..., MLA_NOPE:], pos)], axis=-1)
    kv = split_heads(rmsnorm(c_kv, kv_norm) @ w_ukv, GROUP_HEADS)
    k_pe = jnp.broadcast_to(rope(k_pe[:, None], pos), (b, GROUP_HEADS, t, MLA_ROPE))
    k = jnp.concatenate([kv[..., :MLA_NOPE], k_pe], axis=-1)
    v = kv[..., MLA_NOPE:]
    o = dense_causal_attention(q, k, v, (MLA_NOPE + MLA_ROPE) ** -0.5)
    return merge_heads(o)


def fox_mixer(q, k, v, f_logit, b_f):
    log_f = jax.nn.log_sigmoid(f_logit.astype(jnp.float32) + b_f.astype(jnp.float32))
    fcum = jnp.cumsum(log_f, axis=1).transpose(0, 2, 1)
    o = dense_causal_attention(split_heads(q, GROUP_HEADS), split_heads(k, GROUP_HEADS),
                               split_heads(v, GROUP_HEADS), HEAD_DIM ** -0.5, fcum)
    return merge_heads(o)


def nsa_compress(kv, pos_emb, w1, w2):
    b, g, t, d = kv.shape
    nc = (t - NSA_CMP_LEN) // NSA_CMP_STRIDE + 1
    idx = jnp.arange(nc)[:, None] * NSA_CMP_STRIDE + jnp.arange(NSA_CMP_LEN)[None, :]
    blk = kv[:, :, idx] + pos_emb
    flat = blk.reshape(b, g, nc, NSA_CMP_LEN * d)
    return jax.nn.gelu(flat @ w1) @ w2


def nsa_cmp_sel(qg, k_cmp, v_cmp, ks, vs, tbl):
    b, g, r, t, d = qg.shape
    nb = t // Q_BLOCK
    nc = k_cmp.shape[2]
    ns = t // NSA_SEL_LEN
    n_top = min(NSA_TOP_N, ns)
    scale = d ** -0.5
    cmp_end = jnp.arange(nc) * NSA_CMP_STRIDE + NSA_CMP_LEN - 1
    ci = jnp.arange(nc)[:, None]
    sj = jnp.arange(ns)[None, :]
    overlap = ((ci * NSA_CMP_STRIDE + NSA_CMP_LEN - 1 >= sj * NSA_SEL_LEN)
               & (ci * NSA_CMP_STRIDE <= sj * NSA_SEL_LEN + NSA_SEL_LEN - 1)).astype(jnp.float32)
    ks_blk = ks.reshape(b, g, ns, NSA_SEL_LEN, d)
    vs_blk = vs.reshape(b, g, ns, NSA_SEL_LEN, d)
    bi = jnp.arange(b)[:, None, None, None]
    gi = jnp.arange(g)[None, :, None, None]
    g_ix = jnp.arange(g)[None, :, None, None, None]
    r_ix = jnp.arange(r)[None, None, :, None, None]
    jsel = jnp.arange(ns)
    qb = qg.reshape(b, g, r, nb, Q_BLOCK, d).transpose(3, 0, 1, 2, 4, 5)

    def one_block(args):
        n, qi = args
        qpos = n * Q_BLOCK + jnp.arange(Q_BLOCK)
        sc = jnp.einsum('bgrqd,bgcd->bgrqc', qi, k_cmp, preferred_element_type=jnp.float32) * scale
        dist_c = qpos[:, None] - cmp_end[None, :]
        valid_c = dist_c >= 0
        sc = sc + tbl[:, :, t5_bucket(dist_c)].astype(jnp.float32)
        sc = jnp.where(valid_c, sc, NEG_INF)
        pc = jnp.where(valid_c, jax.nn.softmax(sc, axis=-1), 0.0)
        o_cmp = jnp.einsum('bgrqc,bgcd->bgrqd', pc.astype(v_cmp.dtype), v_cmp)
        imp = jnp.einsum('bgrqc,cs->bgqs', pc, overlap)
        cur = (qpos // NSA_SEL_LEN)[:, None]
        forced = (jsel[None, :] == 0) | (jsel[None, :] == cur) | (jsel[None, :] == cur - 1)
        score = jnp.where(jsel[None, :] <= cur, jnp.where(forced, BIG, imp), NEG_INF)
        _, sel = lax.top_k(score, n_top)
        k_sel = ks_blk[bi, gi, sel].reshape(b, g, Q_BLOCK, n_top * NSA_SEL_LEN, d)
        v_sel = vs_blk[bi, gi, sel].reshape(b, g, Q_BLOCK, n_top * NSA_SEL_LEN, d)
        kpos = (sel[..., None] * NSA_SEL_LEN + jnp.arange(NSA_SEL_LEN)).reshape(b, g, Q_BLOCK, n_top * NSA_SEL_LEN)
        dist_s = qpos[None, None, :, None] - kpos
        ss = jnp.einsum('bgrqd,bgqkd->bgrqk', qi, k_sel, preferred_element_type=jnp.float32) * scale
        ss = ss + tbl[g_ix, r_ix, t5_bucket(dist_s)[:, :, None]].astype(jnp.float32)
        ss = jnp.where(dist_s[:, :, None] >= 0, ss, NEG_INF)
        ps = jax.nn.softmax(ss, axis=-1)
        o_sel = jnp.einsum('bgrqk,bgqkd->bgrqd', ps.astype(v_sel.dtype), v_sel)
        return o_cmp, o_sel

    o_cmp, o_sel = lax.map(one_block, (jnp.arange(nb), qb))
    fix = lambda o: o.transpose(1, 2, 3, 0, 4, 5).reshape(b, g, r, t, d)
    return fix(o_cmp), fix(o_sel)


def nsa_mixer(q, kc, vc, ksl, vsl, kwn, vwn, gate, cmp_pos, cmp_w1, cmp_w2, tbl):
    b, t, _ = q.shape
    g, r = NSA_KV_HEADS, GROUP_HEADS // NSA_KV_HEADS
    qg = split_heads(q, GROUP_HEADS).reshape(b, g, r, t, HEAD_DIM)
    kc, vc = split_heads(kc, g), split_heads(vc, g)
    ksl, vsl = split_heads(ksl, g), split_heads(vsl, g)
    kwn, vwn = split_heads(kwn, g), split_heads(vwn, g)
    k_cmp = nsa_compress(kc, cmp_pos[0], cmp_w1[0], cmp_w2[0])
    v_cmp = nsa_compress(vc, cmp_pos[1], cmp_w1[1], cmp_w2[1])
    o_cmp, o_sel = nsa_cmp_sel(qg, k_cmp, v_cmp, ksl, vsl, tbl)
    o_win = banded_attention(qg, kwn, vwn, NSA_WINDOW, tbl)
    gts = jax.nn.sigmoid(gate).reshape(b, t, g, r, 3).transpose(0, 2, 3, 1, 4)
    o = gts[..., 0:1] * o_cmp + gts[..., 1:2] * o_sel + gts[..., 2:3] * o_win
    return merge_heads(o.reshape(b, GROUP_HEADS, t, HEAD_DIM))


def swa_mixer(q, k, v, sinks, tbl):
    b, t, _ = q.shape
    g, r = SWA_KV_HEADS, GROUP_HEADS // SWA_KV_HEADS
    qg = split_heads(q, GROUP_HEADS).reshape(b, g, r, t, HEAD_DIM)
    o = banded_attention(qg, split_heads(k, g), split_heads(v, g), SWA_WINDOW, tbl, sinks.reshape(g, r))
    return merge_heads(o.reshape(b, GROUP_HEADS, t, HEAD_DIM))


def setup_inputs(seed: int = 0) -> dict:
    key = jax.random.key(seed)
    ks = jax.random.split(key, 20)
    nrm = lambda k, shape, fan_in: jax.random.normal(k, shape, jnp.float32) * fan_in ** -0.5
    gain = lambda k, shape: 1.0 + 0.05 * jax.random.normal(k, shape, jnp.float32)
    L = DEPTH
    return {
        'x': jax.random.normal(ks[0], (BATCH, SEQ, D_MODEL), jnp.float32),
        'norm_attn': gain(ks[1], (L, D_MODEL)),
        'w_in': nrm(ks[2], (L, D_MODEL, IN_COLS), D_MODEL),
        'mla_q_norm': gain(ks[3], (L, MLA_Q_RANK)),
        'mla_w_uq': nrm(ks[4], (L, MLA_Q_RANK, GROUP_HEADS * (MLA_NOPE + MLA_ROPE)), MLA_Q_RANK),
        'mla_kv_norm': gain(ks[5], (L, MLA_KV_RANK)),
        'mla_w_ukv': nrm(ks[6], (L, MLA_KV_RANK, GROUP_HEADS * (MLA_NOPE + MLA_V)), MLA_KV_RANK),
        'fox_b_f': 3.0 + 0.5 * jax.random.normal(ks[7], (L, GROUP_HEADS), jnp.float32),
        'nsa_cmp_pos': 0.1 * jax.random.normal(ks[8], (L, 2, NSA_CMP_LEN, HEAD_DIM), jnp.float32),
        'nsa_cmp_w1': nrm(ks[9], (L, 2, NSA_CMP_LEN * HEAD_DIM, HEAD_DIM), NSA_CMP_LEN * HEAD_DIM),
        'nsa_cmp_w2': nrm(ks[10], (L, 2, HEAD_DIM, HEAD_DIM), HEAD_DIM),
        'swa_sinks': 0.5 * jax.random.normal(ks[11], (L, GROUP_HEADS), jnp.float32),
        'group_norm': gain(ks[12], (L, MIX_WIDTH)),
        'w_out': nrm(ks[13], (L, MIX_WIDTH, D_MODEL), MIX_WIDTH),
        'norm_mlp': gain(ks[14], (L, D_MODEL)),
        'w_up': nrm(ks[15], (L, D_MODEL, D_FF), D_MODEL),
        'w_down': nrm(ks[16], (L, D_FF, D_MODEL), D_FF),
        'rel_bias': 0.5 * jax.random.normal(ks[17], (REL_BUCKETS, REL_HEADS), jnp.float32),
        'final_norm': gain(ks[18], (D_MODEL,)),
    }


def reference(x, norm_attn, w_in, mla_q_norm, mla_w_uq, mla_kv_norm, mla_w_ukv, fox_b_f,
              nsa_cmp_pos, nsa_cmp_w1, nsa_cmp_w2, swa_sinks, group_norm, w_out,
              norm_mlp, w_up, w_down, rel_bias, final_norm):
    b, t, _ = x.shape
    pos = jnp.arange(t)
    r_nsa = GROUP_HEADS // NSA_KV_HEADS
    r_swa = GROUP_HEADS // SWA_KV_HEADS
    tbl_nsa = rel_bias[:, :GROUP_HEADS].T.reshape(NSA_KV_HEADS, r_nsa, REL_BUCKETS)
    tbl_swa = rel_bias[:, GROUP_HEADS:].T.reshape(SWA_KV_HEADS, r_swa, REL_BUCKETS)
    offsets = [int(o) for o in np.cumsum(IN_SPLITS)[:-1]]
    h = x
    for l in range(DEPTH):
        u = rmsnorm(h, norm_attn[l])
        p = jnp.split(u @ w_in[l], offsets, axis=-1)
        o_mla = mla_mixer(p[0], p[1], p[2], mla_q_norm[l], mla_w_uq[l], mla_kv_norm[l], mla_w_ukv[l], pos)
        o_fox = fox_mixer(p[3], p[4], p[5], p[6], fox_b_f[l])
        o_nsa = nsa_mixer(p[7], p[8], p[9], p[10], p[11], p[12], p[13], p[14],
                          nsa_cmp_pos[l], nsa_cmp_w1[l], nsa_cmp_w2[l], tbl_nsa)
        o_swa = swa_mixer(p[15], p[16], p[17], swa_sinks[l], tbl_swa)
        o = jnp.concatenate([o_mla, o_fox, o_nsa, o_swa], axis=-1).reshape(b, t, N_GROUPS, GROUP_WIDTH)
        o = rmsnorm(o, group_norm[l].reshape(N_GROUPS, GROUP_WIDTH)).reshape(b, t, MIX_WIDTH)
        h = h + o @ w_out[l]
        m = rmsnorm(h, norm_mlp[l]) @ w_up[l]
        h = h + jnp.square(jax.nn.relu(m)) @ w_down[l]
    return rmsnorm(h, final_norm)
```

```cpp
#include <hip/hip_runtime.h>
#include <cstdio>
#include <cstdint>
#include <cmath>

#define LAS __attribute__((address_space(3)))
typedef unsigned short bf16_t;
typedef short bf16x8 __attribute__((ext_vector_type(8)));
typedef short s16x4 __attribute__((ext_vector_type(4)));
typedef float f32x4 __attribute__((ext_vector_type(4)));
typedef float f32x2 __attribute__((ext_vector_type(2)));
typedef float f32x16 __attribute__((ext_vector_type(16)));
typedef unsigned u32x4 __attribute__((ext_vector_type(4)));
typedef unsigned u32x2 __attribute__((ext_vector_type(2)));

constexpr int D_MODEL = 2048, BATCH = 4, SEQ = 8192, DEPTH = 2, MTOK = BATCH * SEQ;
constexpr int D_FF = 8192, IN_COLS = 4160;
constexpr float EPS = 1e-6f, NEGF = -1e30f, LOG2E = 1.4426950408889634f;
constexpr int PC_CQ = 0, PC_CKV = 384, PC_KR = 512, PC_FF = 544, PC_GATE = 552, PC_FQ = 576, PC_FK = 1088, PC_NQ = 1600, PC_KC = 2112, PC_VC = 2240,
              PC_KS = 2368, PC_VS = 2496, PC_KW = 2624, PC_SQ = 2752, PC_SK = 3264, PC_END = 3392, PN = 3584;
constexpr int VR_FV = 0, VR_WV = 512, VR_SV = 640, VR_VS = 768, VTN = 1024;
constexpr int MLP_CHUNK = 32768, N_CHUNK = MTOK / MLP_CHUNK;

#ifndef PROBE_DUP
#define PROBE_DUP 0
#endif
#define DUPN(bit) (((PROBE_DUP) >> (bit)) & 1 ? 2 : 1)
__device__ __forceinline__ unsigned f2bf(float f) { unsigned u = __builtin_bit_cast(unsigned, f); return (u + 0x7fffu + ((u >> 16) & 1u)) >> 16; }
typedef __bf16 bf16x2_t __attribute__((ext_vector_type(2)));
__device__ __forceinline__ unsigned pk2(float lo, float hi) { f32x2 v = {lo, hi}; bf16x2_t b = __builtin_convertvector(v, bf16x2_t); return __builtin_bit_cast(unsigned, b); }
__device__ __forceinline__ float bf2f(unsigned short b) { return __builtin_bit_cast(float, (unsigned)b << 16); }
__device__ __forceinline__ float bflo(unsigned w) { return __builtin_bit_cast(float, w << 16); }
__device__ __forceinline__ float bfhi(unsigned w) { return __builtin_bit_cast(float, w & 0xffff0000u); }
#define DPPF(x, CTRL) __builtin_bit_cast(float, __builtin_amdgcn_update_dpp(0, __builtin_bit_cast(int, (x)), (CTRL), 0xF, 0xF, true))
__device__ __forceinline__ float wave_sum(float v) {
    v += DPPF(v, 0xB1); v += DPPF(v, 0x4E); v += DPPF(v, 0x141); v += DPPF(v, 0x140);
    v += __shfl_xor(v, 16); v += __shfl_xor(v, 32);
    return v;
}
__device__ __forceinline__ float wave_max(float v) {
    v = fmaxf(v, DPPF(v, 0xB1)); v = fmaxf(v, DPPF(v, 0x4E)); v = fmaxf(v, DPPF(v, 0x141)); v = fmaxf(v, DPPF(v, 0x140));
    v = fmaxf(v, __shfl_xor(v, 16)); v = fmaxf(v, __shfl_xor(v, 32));
    return v;
}
__device__ __forceinline__ float fexp2(float x) { return __builtin_amdgcn_exp2f(x); }
template <int CTRL> __device__ __forceinline__ float dpp_f(float x) { return __builtin_bit_cast(float, __builtin_amdgcn_update_dpp(0, __builtin_bit_cast(int, x), CTRL, 0xF, 0xF, true)); }
template <int CTRL> __device__ __forceinline__ int dpp_i(int x) { return __builtin_amdgcn_update_dpp(0, x, CTRL, 0xF, 0xF, true); }
#define LDS_FENCE() asm volatile("s_waitcnt lgkmcnt(0)" ::: "memory")

__device__ __forceinline__ int lane_now() { int l; asm volatile("v_mbcnt_lo_u32_b32 %0, -1, 0\n\tv_mbcnt_hi_u32_b32 %0, -1, %0" : "=v"(l)); return l; }
#define XB_TMO      128
#define XB_XCNT(j)  (256  + 64 * (j))
#define XB_XSUB(j)  (1280 + 64 * (j))
#define XB_XGEN(j)  (2304 + 64 * (j))
#define XB_TOP      3328
#define XB_TOPGEN   3392
#define XCD_BAR_WORDS 3456
#define XB_SPIN_CAP (1u << 18)
__device__ __forceinline__ unsigned xb_ld(unsigned* p)              { return __hip_atomic_load(p, __ATOMIC_RELAXED, __HIP_MEMORY_SCOPE_AGENT); }
__device__ __forceinline__ unsigned xb_add(unsigned* p, unsigned v) { return __hip_atomic_fetch_add(p, v, __ATOMIC_RELAXED, __HIP_MEMORY_SCOPE_AGENT); }
__device__ __forceinline__ unsigned xb_xcc_id() { return (unsigned)__builtin_amdgcn_s_getreg((3 << 11) | 20) & 0xFu; }
#define XB_SPIN(cond, bar) do { unsigned _sp = 0; while (cond) { __builtin_amdgcn_s_sleep(1); \
    if ((++_sp & 255u) == 0u) { if (xb_ld(&(bar)[XB_TMO])) break; if (_sp > XB_SPIN_CAP) { atomicAdd(&(bar)[XB_TMO], 1u); break; } } } } while (0)
struct XcdBarrier { unsigned* bar; unsigned x; volatile LAS unsigned* st; int w0; };
__device__ __forceinline__ XcdBarrier xcd_barrier_post(unsigned* bar, volatile LAS unsigned* st) {
    XcdBarrier b; b.bar = bar; b.x = xb_xcc_id(); b.st = st; b.w0 = __builtin_amdgcn_readfirstlane(threadIdx.x >> 6) == 0;
    if (threadIdx.x == 0) (void)xb_add(&bar[XB_XCNT(b.x)], 1u);
    return b;
}
__device__ __forceinline__ void xcd_barrier_complete(unsigned* bar, unsigned x, unsigned& nloc, unsigned& nx) {
    const unsigned G = gridDim.x * gridDim.y * gridDim.z;
    unsigned sum, cnt, mine, sp = 0u;
    for (;;) {
        sum = 0u; cnt = 0u; mine = 0u;
#pragma unroll
        for (unsigned j = 0; j < 16; ++j) { const unsigned c = xb_ld(&bar[XB_XCNT(j)]); sum += c; cnt += (c > 0u) ? 1u : 0u; mine = (j == x) ? c : mine; }
        if (sum == G) break;
        __builtin_amdgcn_s_sleep(1);
        if ((++sp & 255u) == 0u) { if (xb_ld(&bar[XB_TMO])) break; if (sp > XB_SPIN_CAP) { atomicAdd(&bar[XB_TMO], 1u); break; } }
    }
    nloc = mine > 0u ? mine : 1u; nx = cnt > 0u ? cnt : 1u;
}
__device__ __forceinline__ void xcd_barrier(const XcdBarrier& b) {
    asm volatile("s_waitcnt vmcnt(0)" ::: "memory");
    __syncthreads();
    if (b.w0 && lane_now() == 0) {
        unsigned* bar = b.bar;
        __builtin_amdgcn_s_waitcnt(0);
        unsigned nloc = b.st[0], nx = b.st[1];
        if (nloc == 0u) { xcd_barrier_complete(bar, b.x, nloc, nx); b.st[0] = nloc; b.st[1] = nx; }
        const unsigned old = xb_add(&bar[XB_XSUB(b.x)], 1u);
        const unsigned gen = old / nloc;
        if (old + 1u == (gen + 1u) * nloc) {
            __builtin_amdgcn_fence(__ATOMIC_RELEASE, "agent");
            asm volatile("s_waitcnt vmcnt(0)" ::: "memory");
            const unsigned og = xb_add(&bar[XB_TOP], 1u);
            const unsigned tg = og / nx;
            if (og + 1u == (tg + 1u) * nx) xb_add(&bar[XB_TOPGEN], 1u);
            else XB_SPIN(xb_ld(&bar[XB_TOPGEN]) == tg, bar);
            __builtin_amdgcn_fence(__ATOMIC_ACQUIRE, "agent");
            xb_add(&bar[XB_XGEN(b.x)], 1u);
            asm volatile("s_waitcnt vmcnt(0)" ::: "memory");
        } else {
            XB_SPIN(xb_ld(&bar[XB_XGEN(b.x)]) == gen, bar);
            __builtin_amdgcn_fence(__ATOMIC_ACQUIRE, "agent");
            asm volatile("s_waitcnt vmcnt(0)" ::: "memory");
        }
    }
    __syncthreads();
}

namespace pg8 {
constexpr int BM = 256, BK = 64, HALF = 128, HTB = HALF * BK * 2, STAGE_BYTES = 8 * HTB, NXCD = 8, WGM = 8;
__host__ __device__ __forceinline__ int lds_byte(int r, int c) { const int st = (r >> 4) * 2 + (c >> 5), rr = r & 15, cc = c & 31, ob = rr * 64 + cc * 2; return st * 1024 + (ob ^ (((ob >> 9) & 1) << 5)); }
__host__ __device__ __forceinline__ void stage_rc(int b, int& R, int& C) { const int st = b / 1024, sb = b % 1024, swz = sb ^ (((sb >> 9) & 1) << 5); R = (st >> 1) * 16 + swz / 64; C = (st & 1) * 32 + (swz % 64) / 2; }
__host__ __device__ __forceinline__ int perm32(int rho) { const int n = rho >> 4, i = rho & 15; return 8 * (i >> 2) + 4 * n + (i & 3); }
struct Unit { int pm, pn; };
struct Gemm { const bf16_t* A; const bf16_t* Bt; int M, N, K, lda, ldb; };
struct StaticOrder {
    int nM, nN, nwg, G, c;
    __host__ __device__ void init(int M, int N, int G_, int c_) { nM = M / BM; nN = N / BM; nwg = nM * nN; G = G_; c = c_; }
    __host__ __device__ bool next(int i, Unit& u) const {
        const long L = (long)i * G + c; if (L >= nwg) return false;
        int wgid = (int)L; { const int q = nwg / NXCD, r = nwg % NXCD, xcd = wgid % NXCD, off = wgid / NXCD; wgid = (xcd < r ? xcd * (q + 1) : r * (q + 1) + (xcd - r) * q) + off; }
        const int nig = WGM * nN, gid = wgid / nig, fm = gid * WGM, gsz = (nM - fm) < WGM ? (nM - fm) : WGM;
        u.pm = fm + ((wgid % nig) % gsz); u.pn = (wgid % nig) / gsz; return true;
    }
};
__device__ __forceinline__ unsigned cvt_pk_bf16(float lo, float hi) { unsigned r; asm volatile("v_cvt_pk_bf16_f32 %0, %1, %2" : "=v"(r) : "v"(lo), "v"(hi)); return r; }

template <int NV>
__device__ __forceinline__ float rs_ofn(const float* ssrow, float invd) {
    const f32x4* p = (const f32x4*)ssrow; float s = 0.f;
#pragma unroll
    for (int i = 0; i < NV; ++i) { const f32x4 v = p[i]; s += (v[0] + v[1]) + (v[2] + v[3]); }
    return 1.0f / sqrtf(s * invd + 1e-6f);
}
__device__ __forceinline__ float rs_of(const float* ssrow) { return rs_ofn<8>(ssrow, 1.0f / 2048.0f); }
template <int ACT  , int SCALE, int NV = 8, bool MSTAT = false> struct EpiBf16 {
    static constexpr bool PERM = true;
    bf16_t* O; int ldc; const float* ss; float invd; float* mq; float* mkv;
    __device__ __forceinline__ void operator()(const f32x4 (&acc)[2][2][4][2], const Unit& u, int wr, int wc, int fr, int fq) const {
        const int row0 = u.pm * BM + wr * 64 + fr, col0 = u.pn * BM + wc * 64 + 16 * fq;
        f32x4 cs[2][2]; float rsr[2][4];
        if (SCALE == 2) {
            const float mine = rs_ofn<NV>(ss + (size_t)(col0 + fr) * (4 * NV), invd);
#pragma unroll
            for (int bj = 0; bj < 2; ++bj)
#pragma unroll
                for (int n = 0; n < 2; ++n)
#pragma unroll
                    for (int e = 0; e < 4; ++e) cs[bj][n][e] = __shfl(mine, 16 * fq + 8 * bj + 4 * n + e);
        }
        if (SCALE == 1) {
#pragma unroll
            for (int ai = 0; ai < 2; ++ai) { const float mine = rs_ofn<NV>(ss + (size_t)(row0 + ai * HALF + fq * 16) * (4 * NV), invd);
#pragma unroll
                for (int m = 0; m < 4; ++m) rsr[ai][m] = __shfl(mine, fr + 16 * m); }
        }
#pragma unroll
        for (int ai = 0; ai < 2; ++ai)
#pragma unroll
            for (int m = 0; m < 4; ++m) { const int row = row0 + ai * HALF + m * 16; bf16_t* rowp = O + (size_t)row * ldc + col0; float msq = 0.f;
#pragma unroll
                for (int bj = 0; bj < 2; ++bj) { f32x4 v0 = acc[ai][bj][m][0], v1 = acc[ai][bj][m][1];
                    if (SCALE == 1) { v0 = v0 * rsr[ai][m]; v1 = v1 * rsr[ai][m]; }
                    if (SCALE == 2) { v0 = v0 * cs[bj][0]; v1 = v1 * cs[bj][1]; }
                    if (ACT == 2) {
#pragma unroll
                        for (int e = 0; e < 4; ++e) { const float a = fmaxf(v0[e], 0.f), b = fmaxf(v1[e], 0.f); v0[e] = a * a; v1[e] = b * b; } }
                    u32x4 w; w.x = cvt_pk_bf16(v0[0], v0[1]); w.y = cvt_pk_bf16(v0[2], v0[3]); w.z = cvt_pk_bf16(v1[0], v1[1]); w.w = cvt_pk_bf16(v1[2], v1[3]);
                    *(u32x4*)(rowp + bj * 8) = w;
                    if (MSTAT) msq += ((v0[0] * v0[0] + v0[1] * v0[1]) + (v0[2] * v0[2] + v0[3] * v0[3])) + ((v1[0] * v1[0] + v1[1] * v1[1]) + (v1[2] * v1[2] + v1[3] * v1[3])); }
                if (MSTAT) { if (u.pn < 2) { msq += __shfl_xor(msq, 16); msq += __shfl_xor(msq, 32);
                    if (fq == 0) { if (u.pn == 0) mq[(size_t)row * 8 + wc] = msq;
                        else if (wc < 2) { mq[(size_t)row * 8 + 4 + wc] = msq; mkv[(size_t)row * 4 + 2 + wc] = 0.f; }
                        else { mkv[(size_t)row * 4 + wc - 2] = msq; mq[(size_t)row * 8 + 4 + wc] = 0.f; } } } } }
    }
};
struct EpiFp8Relu2 {
    static constexpr bool PERM = true;
    unsigned char* O; int ldc; const float* ss;
    __device__ __forceinline__ void operator()(const f32x4 (&acc)[2][2][4][2], const Unit& u, int wr, int wc, int fr, int fq) const {
        const int row0 = u.pm * BM + wr * 64 + fr, col0 = u.pn * BM + wc * 64 + 16 * fq;
        float rsa[2][4];
#pragma unroll
        for (int ai = 0; ai < 2; ++ai) { const float mine = rs_of(ss + (size_t)(row0 + ai * HALF + fq * 16) * 32);
#pragma unroll
            for (int m = 0; m < 4; ++m) rsa[ai][m] = __shfl(mine, fr + 16 * m); }
#pragma unroll
        for (int ai = 0; ai < 2; ++ai)
#pragma unroll
            for (int m = 0; m < 4; ++m) { const int row = row0 + ai * HALF + m * 16; unsigned char* rowp = O + (size_t)row * ldc + col0;
                const float rsr = rsa[ai][m]; u32x4 wout;
#pragma unroll
                for (int bj = 0; bj < 2; ++bj) { f32x4 v0 = acc[ai][bj][m][0] * rsr, v1 = acc[ai][bj][m][1] * rsr;
#pragma unroll
                    for (int e = 0; e < 4; ++e) { const float a = fmaxf(v0[e], 0.f), b = fmaxf(v1[e], 0.f); v0[e] = fminf(a * a, 448.f); v1[e] = fminf(b * b, 448.f); }
                    int w0 = 0, w1 = 0;
                    w0 = __builtin_amdgcn_cvt_pk_fp8_f32(v0[0], v0[1], w0, false); w0 = __builtin_amdgcn_cvt_pk_fp8_f32(v0[2], v0[3], w0, true);
                    w1 = __builtin_amdgcn_cvt_pk_fp8_f32(v1[0], v1[1], w1, false); w1 = __builtin_amdgcn_cvt_pk_fp8_f32(v1[2], v1[3], w1, true);
                    wout[2 * bj] = (unsigned)w0; wout[2 * bj + 1] = (unsigned)w1; }
                *(u32x4*)rowp = wout; }
    }
};
struct EpiResid {
    static constexpr bool PERM = true;
    bf16_t* hb; float* ss; int ldc;
    __device__ __forceinline__ void operator()(const f32x4 (&acc)[2][2][4][2], const Unit& u, int wr, int wc, int fr, int fq) const {
        const int col0 = u.pn * BM + wc * 64 + 16 * fq;
#pragma unroll
        for (int ai = 0; ai < 2; ++ai)
#pragma unroll
            for (int m = 0; m < 4; ++m) { const int row = u.pm * BM + ai * HALF + wr * 64 + m * 16 + fr; bf16_t* rowp = hb + (size_t)row * ldc + col0;
                float sq = 0.f;
#pragma unroll
                for (int bj = 0; bj < 2; ++bj) { const u32x4 b = *(const u32x4*)(rowp + bj * 8);
                    const f32x4 h0 = acc[ai][bj][m][0] + (f32x4){bflo(b.x), bfhi(b.x), bflo(b.y), bfhi(b.y)}, h1 = acc[ai][bj][m][1] + (f32x4){bflo(b.z), bfhi(b.z), bflo(b.w), bfhi(b.w)};
                    u32x4 w; w.x = cvt_pk_bf16(h0[0], h0[1]); w.y = cvt_pk_bf16(h0[2], h0[3]); w.z = cvt_pk_bf16(h1[0], h1[1]); w.w = cvt_pk_bf16(h1[2], h1[3]);
                    *(u32x4*)(rowp + bj * 8) = w;
                    sq += ((h0[0] * h0[0] + h0[1] * h0[1]) + (h0[2] * h0[2] + h0[3] * h0[3])) + ((h1[0] * h1[0] + h1[1] * h1[1]) + (h1[2] * h1[2] + h1[3] * h1[3])); }
                sq += __shfl_xor(sq, 16); sq += __shfl_xor(sq, 32);
                if (fq == 0) ss[(size_t)row * 32 + u.pn * 4 + wc] = sq; }
    }
};

typedef int i32x8 __attribute__((ext_vector_type(8)));
template <class Epi, class Sched, bool FP8 = false, int SA = 0x7f7f7f7f, int SB = 0x7f7f7f7f>
__device__ __forceinline__ void gemm_phase(LAS unsigned char* lds, const Gemm g, const Sched& S, const Epi& E, int tid_) {
    const int tid = tid_, wid = __builtin_amdgcn_readfirstlane(tid >> 6), lane = tid & 63, wr = wid >> 2, wc = wid & 3, fr = lane & 15, fq = lane >> 4;
    const int K = g.K, nt = K / BK;
    unsigned voffA[2], voffB[2];
#pragma unroll
    for (int i = 0; i < 2; ++i) { int R, C; stage_rc(tid * 16 + i * 8192, R, C); const int Rb = Epi::PERM ? (64 * (R >> 5) + 16 * ((R >> 2) & 3) + 4 * ((R >> 4) & 1) + (R & 3)) : R;
        voffA[i] = (unsigned)(R * g.lda + C) * 2u; voffB[i] = (unsigned)(Rb * g.ldb + C) * 2u; }
    const size_t kstep = (size_t)(BK * 2);
    const size_t hstepA = (size_t)HALF * g.lda * 2, hstepB = (size_t)(Epi::PERM ? 8 : HALF) * g.ldb * 2;
    const size_t tstepA = 2 * hstepA, tstepB = (size_t)BM * g.ldb * 2;
    const unsigned ldsw = (unsigned)wid * 1024u;
    const int aoff = lds_byte(wr * 64 + fr, FP8 ? fq * 16 : fq * 8), boff = lds_byte(wc * 32 + fr, FP8 ? fq * 16 : fq * 8);
#define PG8_SA(b, h) (((b) * 2 + (h)) * HTB)
#define PG8_SB(b, h) ((4 + (b) * 2 + (h)) * HTB)
#define PG8_STAGE(bufoff, gbase, voff) do { _Pragma("unroll") for (int _i = 0; _i < 2; ++_i) \
        __builtin_amdgcn_global_load_lds((const unsigned*)((const char*)(gbase) + (voff)[_i]), (LAS unsigned*)(lds + (bufoff) + ldsw + _i * 8192), 16, 0, 0); } while (0)
#define PG8_LD32(p) __builtin_bit_cast(i32x8, __builtin_shufflevector(*(const LAS bf16x8*)(p), *(const LAS bf16x8*)((p) + 16), 0, 1, 2, 3, 4, 5, 6, 7, 8, 9, 10, 11, 12, 13, 14, 15))
#define PG8_LDA(dst, b, h) do { _Pragma("unroll") for (int m = 0; m < 4; ++m) { if constexpr (FP8) dst##8[m] = PG8_LD32(lds + PG8_SA(b, h) + aoff + m * 2048); \
        else { _Pragma("unroll") for (int k = 0; k < 2; ++k) dst[m][k] = *(const LAS bf16x8*)(lds + PG8_SA(b, h) + aoff + m * 2048 + k * 1024); } } } while (0)
#define PG8_LDB(dst, b, h) do { _Pragma("unroll") for (int n = 0; n < 2; ++n) { if constexpr (FP8) dst##8[n] = PG8_LD32(lds + PG8_SB(b, h) + boff + n * 2048); \
        else { _Pragma("unroll") for (int k = 0; k < 2; ++k) dst[n][k] = *(const LAS bf16x8*)(lds + PG8_SB(b, h) + boff + n * 2048 + k * 1024); } } } while (0)
#define PG8_MMA(ai, bj, At, Bt) do { __builtin_amdgcn_s_setprio(1); _Pragma("unroll") for (int m = 0; m < 4; ++m) _Pragma("unroll") for (int n = 0; n < 2; ++n) { \
        if constexpr (FP8) asm volatile("v_mfma_scale_f32_16x16x128_f8f6f4 %0, %1, %2, %0, %3, %4 op_sel_hi:[0,0,0]" : "+v"(acc[ai][bj][m][n]) : "v"(Bt##8[n]), "v"(At##8[m]), "v"(vsb), "v"(vsa));     \
        else { _Pragma("unroll") for (int k = 0; k < 2; ++k) acc[ai][bj][m][n] = __builtin_amdgcn_mfma_f32_16x16x32_bf16(Bt[n][k], At[m][k], acc[ai][bj][m][n], 0, 0, 0); } } \
        __builtin_amdgcn_s_setprio(0); } while (0)
#define PG8_WAIT_V(n) asm volatile("s_waitcnt vmcnt(" #n ")" ::: "memory")
#define PG8_WAIT_L(n) asm volatile("s_waitcnt lgkmcnt(" #n ")" ::: "memory")
#define PG8_BAR __builtin_amdgcn_s_barrier()
#define PG8_SCHED __builtin_amdgcn_sched_barrier(0)
    Unit cur, nxt; int ui = 0;
    if (!S.next(0, cur)) return;
    f32x4 acc[2][2][4][2];
#pragma unroll
    for (int a = 0; a < 2; ++a)
#pragma unroll
        for (int b = 0; b < 2; ++b)
#pragma unroll
            for (int m = 0; m < 4; ++m)
#pragma unroll
                for (int n = 0; n < 2; ++n) acc[a][b][m][n] = (f32x4){0.f, 0.f, 0.f, 0.f};
    const int vsa = SA, vsb = SB;
    bf16x8 At[4][2], B0[2][2], B1[2][2]; i32x8 At8[4], B08[2], B18[2];
    const char* cA = (const char*)g.A + (size_t)cur.pm * tstepA; const char* cB = (const char*)g.Bt + (size_t)cur.pn * tstepB;
    PG8_STAGE(PG8_SB(0, 0), cB, voffB); PG8_STAGE(PG8_SB(0, 1), cB + hstepB, voffB); PG8_STAGE(PG8_SA(0, 0), cA, voffA); PG8_STAGE(PG8_SA(0, 1), cA + hstepA, voffA);
    if (wr == 1) PG8_BAR;
    PG8_WAIT_V(2); PG8_BAR;
    PG8_STAGE(PG8_SB(1, 0), cB + kstep, voffB); PG8_STAGE(PG8_SA(1, 0), cA + kstep, voffA); PG8_STAGE(PG8_SB(1, 1), cB + hstepB + kstep, voffB);
    PG8_WAIT_V(6); PG8_BAR;
    for (;;) {
        const bool has_next = S.next(ui + 1, nxt);
        const char* nA = has_next ? (const char*)g.A + (size_t)nxt.pm * tstepA : cA; const char* nB = has_next ? (const char*)g.Bt + (size_t)nxt.pn * tstepB : cB;
#pragma unroll 1
        for (int t = 0; t < nt; t += 2) {
            const bool last = (t == nt - 2);
            const char* a1 = cA + (size_t)(t + 1) * kstep;
            const char* a2 = last ? nA : cA + (size_t)(t + 2) * kstep; const char* b2 = last ? nB : cB + (size_t)(t + 2) * kstep;
            const char* a3 = a2 + kstep; const char* b3 = b2 + kstep;
            PG8_LDB(B0, 0, 0); PG8_LDB(B1, 0, 1); PG8_SCHED; PG8_LDA(At, 0, 0); PG8_STAGE(PG8_SA(1, 1), a1 + hstepA, voffA);
            PG8_WAIT_V(8); PG8_WAIT_L(0); PG8_BAR; PG8_MMA(0, 0, At, B0); PG8_MMA(0, 1, At, B1); PG8_BAR; PG8_SCHED;
            PG8_LDA(At, 0, 1); PG8_STAGE(PG8_SB(0, 0), b2, voffB); PG8_STAGE(PG8_SB(0, 1), b2 + hstepB, voffB); PG8_STAGE(PG8_SA(0, 0), a2, voffA);
            PG8_WAIT_V(8); PG8_WAIT_L(0); PG8_BAR; PG8_MMA(1, 0, At, B0); PG8_MMA(1, 1, At, B1); PG8_BAR; PG8_SCHED;
            PG8_LDB(B0, 1, 0); PG8_LDB(B1, 1, 1); PG8_SCHED; PG8_LDA(At, 1, 0); PG8_STAGE(PG8_SA(0, 1), a2 + hstepA, voffA);
            PG8_WAIT_V(8); PG8_WAIT_L(0); PG8_BAR; PG8_MMA(0, 0, At, B0); PG8_MMA(0, 1, At, B1); PG8_BAR; PG8_SCHED;
            PG8_LDA(At, 1, 1); PG8_STAGE(PG8_SB(1, 0), b3, voffB); PG8_STAGE(PG8_SB(1, 1), b3 + hstepB, voffB); PG8_STAGE(PG8_SA(1, 0), a3, voffA);
            PG8_WAIT_V(8); PG8_WAIT_L(0); PG8_BAR; PG8_MMA(1, 0, At, B0); PG8_MMA(1, 1, At, B1); PG8_BAR; PG8_SCHED;
        }
        if (wr == 0) PG8_BAR;
        if constexpr (FP8) asm volatile("s_nop 15\n\ts_nop 15" ::: "memory");
        E(acc, cur, wr, wc, fr, fq);
        if (!has_next) break;
#pragma unroll
        for (int a = 0; a < 2; ++a)
#pragma unroll
            for (int b = 0; b < 2; ++b)
#pragma unroll
                for (int m = 0; m < 4; ++m)
#pragma unroll
                    for (int n = 0; n < 2; ++n) acc[a][b][m][n] = (f32x4){0.f, 0.f, 0.f, 0.f};
        cur = nxt; cA = nA; cB = nB; ++ui;
        if (wr == 1) PG8_BAR;
    }
    PG8_WAIT_V(0);
    PG8_BAR;
#undef PG8_SA
#undef PG8_SB
#undef PG8_STAGE
#undef PG8_LDA
#undef PG8_LDB
#undef PG8_MMA
#undef PG8_LD32
#undef PG8_WAIT_V
#undef PG8_WAIT_L
#undef PG8_BAR
#undef PG8_SCHED
}
}

constexpr size_t MiB = 1u << 20;
constexpr size_t WS_CTL = 0, CTL_ZERO_BYTES = 64 * 1024;
constexpr size_t SZ_WIN = (size_t)PN * D_MODEL * 2, SZ_WINV = (size_t)VTN * D_MODEL * 2, SZ_WUQ = (size_t)768 * 384 * 2, SZ_WUKVK = (size_t)512 * 256 * 2, SZ_WUKVV = (size_t)512 * 256 * 2,
                 SZ_WOUT = (size_t)D_MODEL * D_MODEL * 2, SZ_WUP = (size_t)D_FF * D_MODEL * 2, SZ_WDN = (size_t)D_MODEL * D_FF * 2, SZ_W1T = (size_t)2 * 64 * 2048 * 2, SZ_CB1 = 2 * 64 * 4;
constexpr size_t WL_WIN = 0, WL_WINV = WL_WIN + SZ_WIN, WL_WUQ = WL_WINV + SZ_WINV, WL_WUKVK = WL_WUQ + SZ_WUQ, WL_WUKVV = WL_WUKVK + SZ_WUKVK, WL_WOUT = WL_WUKVV + SZ_WUKVV,
                 WL_WUP = WL_WOUT + SZ_WOUT, WL_WDN = WL_WUP + SZ_WUP, WL_W1T = WL_WDN + SZ_WDN, WL_CB1 = WL_W1T + SZ_W1T, WL_SIZE = ((WL_CB1 + SZ_CB1 + 4095) / 4096) * 4096;
constexpr size_t WS_W = 1 * MiB;
constexpr size_t WS_ACT = WS_W + DEPTH * WL_SIZE;
constexpr size_t WS_P = WS_ACT + (size_t)MTOK * D_MODEL * 2;
constexpr size_t WS_VT = WS_P + (size_t)MTOK * PN * 2;
constexpr size_t WS_MQ = WS_VT + (size_t)1024 * MTOK * 2;
constexpr size_t WS_MK = WS_MQ + (size_t)MTOK * 768 * 2;
constexpr size_t WS_MVT = WS_MK + (size_t)MTOK * 512 * 2;
constexpr size_t WS_OC = WS_MVT + (size_t)512 * MTOK * 2;
constexpr size_t WS_OS = WS_OC + (size_t)MTOK * 512 * 2, WS_OW = WS_OS + (size_t)MTOK * 512 * 2;
constexpr size_t WS_FC = WS_OW + (size_t)MTOK * 512 * 2;
constexpr size_t WS_KCMP = WS_FC + (size_t)BATCH * 8 * SEQ * 4;
constexpr size_t WS_VCMPT = WS_KCMP + (size_t)BATCH * 2 * 512 * 64 * 2;
constexpr size_t WS_KT = WS_VCMPT + (size_t)BATCH * 2 * 64 * 512 * 2 + 65536;
constexpr size_t WS_HB = WS_KT + 2 * (size_t)BATCH * 8 * 128 * 4 + 32768;
constexpr size_t WS_SS = WS_HB + (size_t)MTOK * D_MODEL * 2;
constexpr size_t WS_KR = WS_SS + 5 * (size_t)MTOK * 32 * 4;
constexpr size_t WS_MSQ = WS_KR + (size_t)MTOK * 32 * 2, WS_MSKV = WS_MSQ + (size_t)MTOK * 8 * 4;
constexpr size_t WS_END = WS_MSKV + (size_t)MTOK * 4 * 4;
static_assert((size_t)MLP_CHUNK * D_FF <= (size_t)MTOK * PN * 2 + (size_t)1024 * MTOK * 2, "hidden (fp8) overlays P and VT (both dead during the MLP)");

constexpr int RING_BYTES = 131072, LDS_BYTES = 163840, LDSCTL_OFF = LDS_BYTES - 1024;
constexpr int A_K = 0, A_KSTR64 = 144, A_KSTR96 = 208, A_V = 13312, A_VSTR = 136, A_FK = A_V + 64 * A_VSTR;
constexpr int N_KS = 64 * A_KSTR64, N_VS = 64 * A_VSTR, N_K0 = 0, N_V0 = 2 * N_KS, A_IMP = N_V0 + 2 * N_VS, A_END = A_IMP + 65536;
constexpr int SW_BYTES = 64 * A_KSTR64 + 64 * A_VSTR;
constexpr int A_TBSTR = 132, A_TB = 8 * SW_BYTES, A_SEL = A_TB + 8 * A_TBSTR * 4, A_WM = A_SEL + 1024, A_TOP = A_WM + 128;
static_assert(A_END <= RING_BYTES && A_TOP <= LDSCTL_OFF && A_TB >= RING_BYTES, "attention LDS map");

struct Frame {
    LAS unsigned char* lds;
    int tid, lane, wave, G, c;
    const float* in[19]; float* out; unsigned char* ws;
};

struct ColMap { int src; float cs; };
constexpr float QSC = 0.125f * LOG2E;
constexpr float MLA_QSC = 0.10206207261596575f * LOG2E;
__device__ __forceinline__ ColMap map_win_rm(int n) {
    ColMap r; r.cs = 1.f;
    if (n < 544) r.src = n;
    else if (n < 552) r.src = 2080 + (n - 544);
    else if (n < 576) r.src = 3368 + (n - 552);
    else if (n < 1088) { r.src = 544 + (n - 576); r.cs = QSC; }
    else if (n < 1600) r.src = 1056 + (n - 1088);
    else if (n < 2112) { r.src = 2088 + (n - 1600); r.cs = QSC; }
    else if (n < 2240) r.src = 2600 + (n - 2112);
    else if (n < 2368) r.src = 2728 + (n - 2240);
    else if (n < 2496) r.src = 2856 + (n - 2368);
    else if (n < 2624) r.src = 2984 + (n - 2496);
    else if (n < 2752) r.src = 3112 + (n - 2624);
    else if (n < 3264) { r.src = 3392 + (n - 2752); r.cs = QSC; }
    else if (n < 3392) r.src = 3904 + (n - 3264);
    else r.src = -1;
    return r;
}
__device__ __forceinline__ ColMap map_win_v(int n) {
    ColMap r; r.cs = 1.f;
    if (n < 512) r.src = 1568 + n;
    else if (n < 640) r.src = 3240 + (n - 512);
    else if (n < 768) r.src = 4032 + (n - 640);
    else if (n < 896) r.src = 2984 + (n - 768);
    else r.src = -1;
    return r;
}
__device__ __forceinline__ ColMap map_id(int n) { ColMap r; r.src = n; r.cs = 1.f; return r; }
__device__ __forceinline__ ColMap map_uq(int n) { ColMap r; r.src = n; r.cs = MLA_QSC; return r; }
__device__ __forceinline__ ColMap map_ukv_k(int n) { ColMap r; r.src = (n >> 6) * 128 + (n & 63); r.cs = 1.f; return r; }
__device__ __forceinline__ ColMap map_ukv_v(int n) { ColMap r; r.src = (n >> 6) * 128 + 64 + (n & 63); r.cs = 1.f; return r; }

template <class MapF>
__device__ __forceinline__ void titem_load(f32x4 (&tv)[8], float (&tsc)[8], unsigned char*& tdst, int& tK, bool& tfp8, const float* W, int Krows, int Nsrc, void* WT, int K, const float* rowgain, MapF mapf, int item, int nblk, int lane, bool fp8) {
    const int kb = item / nblk, nb = item % nblk, k0 = 64 * kb, n0 = 32 * nb;
    const int kr = lane >> 3, nc = 4 * (lane & 7);
    const ColMap cm = mapf(n0 + nc);
#pragma unroll
    for (int i = 0; i < 8; ++i) { const int k = k0 + 8 * i + kr; const bool ok = cm.src >= 0 && k < Krows;
        tv[i] = (f32x4){0.f, 0.f, 0.f, 0.f}; tsc[i] = fp8 ? 64.0f * cm.cs : cm.cs;
        if (ok) { tv[i] = *(const f32x4*)(W + (size_t)k * Nsrc + cm.src); if (rowgain) tsc[i] *= rowgain[k]; } }
    tdst = (unsigned char*)WT + ((size_t)n0 * K + k0) * (fp8 ? 1 : 2); tK = K; tfp8 = fp8;
}
__device__ __forceinline__ void titem_finish(const f32x4 (&tv)[8], const float (&tsc)[8], unsigned char* tdst, int tK, bool tfp8, LAS float* scr, int lane) {
    const int kr = lane >> 3, nc = 4 * (lane & 7);
#pragma unroll
    for (int i = 0; i < 8; ++i) *(LAS f32x4*)(scr + (8 * i + kr) * 36 + nc) = tv[i] * tsc[i];
    LDS_FENCE();
    if (tfp8) {
        const int n = lane >> 1, kh = 32 * (lane & 1);
        const LAS float* s = scr + kh * 36 + n;
        u32x4 o[2];
#pragma unroll
        for (int q = 0; q < 2; ++q)
#pragma unroll
            for (int d = 0; d < 4; ++d) { const LAS float* p = s + (16 * q + 4 * d) * 36; int w = 0;
                w = __builtin_amdgcn_cvt_pk_fp8_f32(p[0], p[36], w, false); w = __builtin_amdgcn_cvt_pk_fp8_f32(p[72], p[108], w, true); o[q][d] = (unsigned)w; }
        unsigned char* dp = tdst + (size_t)n * tK + kh;
        *(u32x4*)dp = o[0]; *(u32x4*)(dp + 16) = o[1];
    } else {
        const int c = lane & 7;
#pragma unroll
        for (int j = 0; j < 4; ++j) { const int n = (lane >> 3) + 8 * j; const LAS float* s = scr + (8 * c) * 36 + n;
            u32x4 o; o.x = pk2(s[0 * 36], s[1 * 36]); o.y = pk2(s[2 * 36], s[3 * 36]); o.z = pk2(s[4 * 36], s[5 * 36]); o.w = pk2(s[6 * 36], s[7 * 36]);
            *(u32x4*)(tdst + ((size_t)n * tK + 8 * c) * 2) = o; }
    }
    LDS_FENCE();
}

__device__ __forceinline__ void row_to_bf16_ss(const float* xrow, bf16_t* orow, float* ssp, int lane) {
    const f32x4* xr = (const f32x4*)xrow + lane;
    f32x4 v[8]; float s = 0.f;
#pragma unroll
    for (int j = 0; j < 8; ++j) { v[j] = xr[64 * j]; s += (v[j].x * v[j].x + v[j].y * v[j].y) + (v[j].z * v[j].z + v[j].w * v[j].w); }
    s = wave_sum(s);
    u32x2* o8 = (u32x2*)orow + lane;
#pragma unroll
    for (int j = 0; j < 8; ++j) { u32x2 w; w.x = pk2(v[j].x, v[j].y); w.y = pk2(v[j].z, v[j].w); o8[64 * j] = w; }
    if (lane < 32) ssp[lane] = lane == 0 ? s : 0.f;
}
__device__ __forceinline__ void rms_row_final(const bf16_t* hrow, float* orow, const float* gain, const float* ssrow, int lane) {
    const float rs = pg8::rs_of(ssrow);
#pragma unroll
    for (int j = 0; j < 4; ++j) { const u32x4 b = *((const u32x4*)hrow + lane + 64 * j);
        const f32x4 g0 = *((const f32x4*)gain + 2 * (lane + 64 * j)), g1 = *((const f32x4*)gain + 2 * (lane + 64 * j) + 1);
        *((f32x4*)orow + 2 * (lane + 64 * j)) = (f32x4){bflo(b.x), bfhi(b.x), bflo(b.y), bfhi(b.y)} * rs * g0;
        *((f32x4*)orow + 2 * (lane + 64 * j) + 1) = (f32x4){bflo(b.z), bfhi(b.z), bflo(b.w), bfhi(b.w)} * rs * g1; }
}

__device__ __forceinline__ void prologue(Frame& F) {
    LAS float* scr = (LAS float*)(F.lds + F.wave * 16384);
    const int gw = F.c * 8 + F.wave, NGW = F.G * 8;
    for (int L = 0; L < DEPTH; ++L) {
        unsigned char* wl = F.ws + WS_W + (size_t)L * WL_SIZE;
        const float* w_in = F.in[2] + (size_t)L * D_MODEL * IN_COLS;
        const float* g_attn = F.in[1] + (size_t)L * D_MODEL;
        constexpr int I_WIN = 32 * (PN / 32), I_WINV = 32 * (VTN / 32), I_UQ = 6 * 24, I_UKV = 4 * 16, I_OUT = 32 * 64, I_UP = 32 * 256, I_DN = 128 * 64, I_W1 = 32 * 2;
        constexpr int NITEMS = I_WIN + I_WINV + I_UQ + 2 * I_UKV + I_OUT + I_UP + I_DN + 2 * I_W1;
#define PRO_LOAD(T, it_) do { int r = (it_); int lane_ = F.lane; asm volatile("" : "+v"(lane_)); \
            if (r < I_WIN) { titem_load(T##v, T##sc, T##dst, T##K, T##fp8, w_in, D_MODEL, IN_COLS, wl + WL_WIN, D_MODEL, g_attn, map_win_rm, r, PN / 32, lane_, false); break; } r -= I_WIN; \
            if (r < I_WINV) { titem_load(T##v, T##sc, T##dst, T##K, T##fp8, w_in, D_MODEL, IN_COLS, wl + WL_WINV, D_MODEL, g_attn, map_win_v, r, VTN / 32, lane_, false); break; } r -= I_WINV; \
            if (r < I_UQ) { titem_load(T##v, T##sc, T##dst, T##K, T##fp8, F.in[4] + (size_t)L * 384 * 768, 384, 768, wl + WL_WUQ, 384, F.in[3] + L * 384, map_uq, r, 24, lane_, false); break; } r -= I_UQ; \
            if (r < I_UKV) { titem_load(T##v, T##sc, T##dst, T##K, T##fp8, F.in[6] + (size_t)L * 128 * 1024, 128, 1024, wl + WL_WUKVK, 256, F.in[5] + L * 128, map_ukv_k, r, 16, lane_, false); break; } r -= I_UKV; \
            if (r < I_UKV) { titem_load(T##v, T##sc, T##dst, T##K, T##fp8, F.in[6] + (size_t)L * 128 * 1024, 128, 1024, wl + WL_WUKVV, 256, F.in[5] + L * 128, map_ukv_v, r, 16, lane_, false); break; } r -= I_UKV; \
            if (r < I_OUT) { titem_load(T##v, T##sc, T##dst, T##K, T##fp8, F.in[13] + (size_t)L * D_MODEL * D_MODEL, D_MODEL, D_MODEL, wl + WL_WOUT, D_MODEL, F.in[12] + L * D_MODEL, map_id, r, 64, lane_, true); break; } r -= I_OUT; \
            if (r < I_UP) { titem_load(T##v, T##sc, T##dst, T##K, T##fp8, F.in[15] + (size_t)L * D_MODEL * D_FF, D_MODEL, D_FF, wl + WL_WUP, D_MODEL, F.in[14] + L * D_MODEL, map_id, r, 256, lane_, false); break; } r -= I_UP; \
            if (r < I_DN) { titem_load(T##v, T##sc, T##dst, T##K, T##fp8, F.in[16] + (size_t)L * D_FF * D_MODEL, D_FF, D_MODEL, wl + WL_WDN, D_FF, nullptr, map_id, r, 64, lane_, true); break; } r -= I_DN; \
            { const int kv = r / I_W1; r -= kv * I_W1; \
              titem_load(T##v, T##sc, T##dst, T##K, T##fp8, F.in[9] + ((size_t)L * 2 + kv) * 2048 * 64, 2048, 64, (bf16_t*)(wl + WL_W1T) + (size_t)kv * 64 * 2048, 2048, nullptr, map_id, r, 2, lane_, false); } } while (0)
        for (int it = gw; it < NITEMS; it += 2 * NGW) {
            f32x4 tav[8], tbv[8]; float tasc[8], tbsc[8]; unsigned char* tadst; unsigned char* tbdst = nullptr; int taK, tbK = 0; bool tafp8, tbfp8 = false; const bool hb = it + NGW < NITEMS;
            PRO_LOAD(ta, it);
            if (hb) PRO_LOAD(tb, it + NGW);
            titem_finish(tav, tasc, tadst, taK, tafp8, scr, F.lane);
            if (hb) titem_finish(tbv, tbsc, tbdst, tbK, tbfp8, scr, F.lane);
        }
#undef PRO_LOAD
        for (int it = gw; it < 128; it += NGW) { const int kv = it >> 6, n = it & 63;
            const float* pos = F.in[8] + ((size_t)L * 2 + kv) * 2048; const float* w1 = F.in[9] + ((size_t)L * 2 + kv) * 2048 * 64;
            float s = 0.f;
            for (int k = F.lane; k < 2048; k += 64) s += pos[k] * w1[(size_t)k * 64 + n];
            s = wave_sum(s);
            if (F.lane == 0) ((float*)(wl + WL_CB1))[it] = s; }
    }
    bf16_t* HB = (bf16_t*)(F.ws + WS_HB); float* ss0 = (float*)(F.ws + WS_SS);
    for (int m = gw; m < MTOK; m += NGW) row_to_bf16_ss(F.in[0] + (size_t)m * D_MODEL, HB + (size_t)m * D_MODEL, ss0 + (size_t)m * 32, F.lane);
}

__device__ __forceinline__ float rope_inv(int i) { return exp2f(-(float)i * (13.287712379549449f / 16.0f)); }

__device__ __forceinline__ void rope_sincos(int pos, int i, float& sn, float& cs) {
    const float ang = (float)pos * rope_inv(i);
    const double rev = (double)ang * 0.15915494309189535; const float fr = (float)(rev - floor(rev));
    sn = __builtin_amdgcn_sinf(fr); cs = __builtin_amdgcn_cosf(fr);
}
__device__ __forceinline__ void krope_tokens(const bf16_t* P, bf16_t* KR, int tok0, int lane) {
    const int tok = tok0 + (lane >> 4), i = lane & 15;
    const bf16_t* prow = P + (size_t)tok * PN + PC_KR;
    const float x1 = bf2f(prow[i]), x2 = bf2f(prow[16 + i]);
    float sn, cs; rope_sincos(tok & (SEQ - 1), i, sn, cs);
    KR[(size_t)tok * 32 + i] = (bf16_t)f2bf(x1 * cs - x2 * sn); KR[(size_t)tok * 32 + 16 + i] = (bf16_t)f2bf(x1 * sn + x2 * cs);
}

__device__ __forceinline__ void fox_scan_seq(Frame& F, const bf16_t* P, const float* bf, float* fc, int seq) {
    const int b = seq >> 3, h = seq & 7; const float bias = bf[h];
    LAS float* sc = (LAS float*)(F.lds);
    const int t0 = F.tid * 16; float v[16]; float run = 0.f;
#pragma unroll
    for (int i = 0; i < 16; ++i) { const float x = bf2f(P[(size_t)(b * SEQ + t0 + i) * PN + PC_FF + h]) + bias;
        const float ls = fminf(x, 0.f) - log1pf(expf(-fabsf(x))); run += ls * LOG2E; v[i] = run; }
    float incl = run;
#pragma unroll
    for (int o = 1; o < 64; o <<= 1) { const float n = __shfl_up(incl, o); if (F.lane >= o) incl += n; }
    if (F.lane == 63) sc[F.wave] = incl;
    __syncthreads();
    float woff = 0.f;
    for (int w = 0; w < F.wave; ++w) woff += sc[w];
    const float excl = woff + incl - run;
    float* o = fc + (size_t)seq * SEQ + t0;
#pragma unroll
    for (int i = 0; i < 16; i += 4) *(f32x4*)(o + i) = (f32x4){v[i] + excl, v[i + 1] + excl, v[i + 2] + excl, v[i + 3] + excl};
    __syncthreads();
}

__device__ __forceinline__ void fox_norm_tile(const bf16_t* P, float* kt, float* qt, int item, int lane) {
    const int t = item & 127, bh = item >> 7, b = bh >> 3, h = bh & 7;
    const bf16_t* row = P + (size_t)(b * SEQ + 64 * t + lane) * PN + h * 64;
    float sk = 0.f, sq = 0.f;
#pragma unroll
    for (int c = 0; c < 8; ++c) { const u32x4 kk = *(const u32x4*)(row + PC_FK + 8 * c), qq = *(const u32x4*)(row + PC_FQ + 8 * c);
        sk += (bflo(kk.x) * bflo(kk.x) + bfhi(kk.x) * bfhi(kk.x)) + (bflo(kk.y) * bflo(kk.y) + bfhi(kk.y) * bfhi(kk.y)) + (bflo(kk.z) * bflo(kk.z) + bfhi(kk.z) * bfhi(kk.z)) + (bflo(kk.w) * bflo(kk.w) + bfhi(kk.w) * bfhi(kk.w));
        sq += (bflo(qq.x) * bflo(qq.x) + bfhi(qq.x) * bfhi(qq.x)) + (bflo(qq.y) * bflo(qq.y) + bfhi(qq.y) * bfhi(qq.y)) + (bflo(qq.z) * bflo(qq.z) + bfhi(qq.z) * bfhi(qq.z)) + (bflo(qq.w) * bflo(qq.w) + bfhi(qq.w) * bfhi(qq.w)); }
    sk = wave_max(sk); sq = wave_max(sq);
    if (lane == 0) { kt[item] = sqrtf(sk); qt[item] = sqrtf(sq); }
}

__device__ __forceinline__ float gelu_tanh(float x) { const float u = 0.7978845608028654f * (x + 0.044715f * x * x * x); return 0.5f * x * (1.f + tanhf(u)); }
__device__ __forceinline__ void nsa_compress_item(Frame& F, int item, const bf16_t* P, const bf16_t* w1t, const float* cb1, const float* w2, bf16_t* kcmp, bf16_t* vcmpt) {
    const int ct = item & 15, g = (item >> 4) & 1, kv = (item >> 5) & 1, b = item >> 6;
    const int lane = F.lane, r32 = lane & 31, hi = lane >> 5;
    const int c = ct * 32 + r32, cl = c > 510 ? 510 : c;
    const bf16_t* arow = P + (size_t)(b * SEQ + 16 * cl) * PN + (kv ? PC_VC : PC_KC) + g * 64 + 8 * hi;
    const bf16_t* w1k = w1t + (size_t)kv * 64 * 2048;
    f32x16 acc0, acc1;
#pragma unroll
    for (int i = 0; i < 16; ++i) { acc0[i] = 0.f; acc1[i] = 0.f; }
#pragma unroll
    for (int li = 0; li < 4; ++li) { const int l = F.wave * 4 + li;
#pragma unroll
        for (int s = 0; s < 4; ++s) {
            const bf16x8 a = *(const bf16x8*)(arow + (size_t)l * PN + 16 * s);
            const bf16x8 b0 = *(const bf16x8*)(w1k + (size_t)r32 * 2048 + l * 64 + 16 * s + 8 * hi);
            const bf16x8 b1 = *(const bf16x8*)(w1k + (size_t)(32 + r32) * 2048 + l * 64 + 16 * s + 8 * hi);
            acc0 = __builtin_amdgcn_mfma_f32_32x32x16_bf16(a, b0, acc0, 0, 0, 0);
            acc1 = __builtin_amdgcn_mfma_f32_32x32x16_bf16(a, b1, acc1, 0, 0, 0); } }
    LAS float* red = (LAS float*)(F.lds);
    LAS float* hid = (LAS float*)(F.lds + 65536);
#pragma unroll
    for (int r = 0; r < 16; ++r) { const int cc = (r & 3) + 8 * (r >> 2) + 4 * hi;
        red[(F.wave * 32 + cc) * 64 + r32] = acc0[r]; red[(F.wave * 32 + cc) * 64 + 32 + r32] = acc1[r]; }
    __syncthreads();
#pragma unroll
    for (int i = 0; i < 4; ++i) { const int idx = F.tid + 512 * i, cc = idx >> 6, n = idx & 63;
        float s = cb1[kv * 64 + n];
#pragma unroll
        for (int w = 0; w < 8; ++w) s += red[(w * 32 + cc) * 64 + n];
        hid[cc * 65 + n] = gelu_tanh(s); }
    __syncthreads();
    const float* w2k = w2 + (size_t)kv * 64 * 64;
    float w2r[64];
#pragma unroll
    for (int n = 0; n < 64; ++n) w2r[n] = w2k[n * 64 + (F.tid & 63)];
#pragma unroll
    for (int i = 0; i < 4; ++i) { const int idx = F.tid + 512 * i, cc = idx >> 6, n2 = idx & 63;
        float s = 0.f;
#pragma unroll
        for (int n = 0; n < 64; ++n) s += hid[cc * 65 + n] * w2r[n];
        const int co = ct * 32 + cc; if (co > 510) s = 0.f;
        if (kv == 0) kcmp[((size_t)(b * 2 + g) * 512 + co) * 64 + n2] = (bf16_t)f2bf(s);
        else vcmpt[((size_t)(b * 2 + g) * 64 + n2) * 512 + co] = (bf16_t)f2bf(s); }
    __syncthreads();
}

template <int NT>
__device__ __forceinline__ void combine_norm_tokens(const bf16_t* O, unsigned char* O8, const bf16_t* P, const bf16_t* OC, const bf16_t* OS, const bf16_t* OW, int m0, int mstep, int lane) {
    u32x4 v[NT][4], pa[NT], pb[NT], pc[NT]; float g[NT][3];
    const int head = lane >> 3;
#pragma unroll
    for (int t = 0; t < NT; ++t) { const size_t m = (size_t)(m0 + t * mstep); const bf16_t* orow = O + m * D_MODEL; const bf16_t* prow = P + m * PN;
        v[t][0] = *(const u32x4*)(orow + 8 * lane); v[t][1] = *(const u32x4*)(orow + 512 + 8 * lane); v[t][3] = *(const u32x4*)(orow + 1536 + 8 * lane);
        pa[t] = *(const u32x4*)(OC + m * 512 + 8 * lane); pb[t] = *(const u32x4*)(OS + m * 512 + 8 * lane); pc[t] = *(const u32x4*)(OW + m * 512 + 8 * lane);
#pragma unroll
        for (int i = 0; i < 3; ++i) g[t][i] = bf2f(prow[PC_GATE + head * 3 + i]); }
    float f[NT][4][8], ss[NT][4];
#pragma unroll
    for (int t = 0; t < NT; ++t) {
        const float g0 = 1.f / (1.f + expf(-g[t][0])), g1 = 1.f / (1.f + expf(-g[t][1])), g2 = 1.f / (1.f + expf(-g[t][2]));
#pragma unroll
        for (int grp = 0; grp < 4; ++grp) {
            if (grp != 2) { const u32x4 x = v[t][grp];
                f[t][grp][0] = bflo(x.x); f[t][grp][1] = bfhi(x.x); f[t][grp][2] = bflo(x.y); f[t][grp][3] = bfhi(x.y); f[t][grp][4] = bflo(x.z); f[t][grp][5] = bfhi(x.z); f[t][grp][6] = bflo(x.w); f[t][grp][7] = bfhi(x.w);
            } else { const u32x4 a = pa[t], bq = pb[t], cq = pc[t];
                f[t][2][0] = g0 * bflo(a.x) + g1 * bflo(bq.x) + g2 * bflo(cq.x); f[t][2][1] = g0 * bfhi(a.x) + g1 * bfhi(bq.x) + g2 * bfhi(cq.x);
                f[t][2][2] = g0 * bflo(a.y) + g1 * bflo(bq.y) + g2 * bflo(cq.y); f[t][2][3] = g0 * bfhi(a.y) + g1 * bfhi(bq.y) + g2 * bfhi(cq.y);
                f[t][2][4] = g0 * bflo(a.z) + g1 * bflo(bq.z) + g2 * bflo(cq.z); f[t][2][5] = g0 * bfhi(a.z) + g1 * bfhi(bq.z) + g2 * bfhi(cq.z);
                f[t][2][6] = g0 * bflo(a.w) + g1 * bflo(bq.w) + g2 * bflo(cq.w); f[t][2][7] = g0 * bfhi(a.w) + g1 * bfhi(bq.w) + g2 * bfhi(cq.w); }
            float s = 0.f;
#pragma unroll
            for (int i = 0; i < 8; ++i) s += f[t][grp][i] * f[t][grp][i];
            ss[t][grp] = s; } }
#pragma unroll
    for (int t = 0; t < NT; ++t)
#pragma unroll
        for (int grp = 0; grp < 4; ++grp) ss[t][grp] = wave_sum(ss[t][grp]);
#pragma unroll
    for (int t = 0; t < NT; ++t) { unsigned char* orow = O8 + (size_t)(m0 + t * mstep) * D_MODEL;
#pragma unroll
        for (int grp = 0; grp < 4; ++grp) { const float rs = 1.0f / sqrtf(ss[t][grp] * (1.f / 512.f) + EPS); const float* ff = f[t][grp];
            int w0 = 0, w1 = 0;
            w0 = __builtin_amdgcn_cvt_pk_fp8_f32(ff[0] * rs, ff[1] * rs, w0, false); w0 = __builtin_amdgcn_cvt_pk_fp8_f32(ff[2] * rs, ff[3] * rs, w0, true);
            w1 = __builtin_amdgcn_cvt_pk_fp8_f32(ff[4] * rs, ff[5] * rs, w1, false); w1 = __builtin_amdgcn_cvt_pk_fp8_f32(ff[6] * rs, ff[7] * rs, w1, true);
            *(u32x2*)(orow + grp * 512 + 8 * lane) = (u32x2){(unsigned)w0, (unsigned)w1}; } }
}

__device__ __forceinline__ int crow(int r, int hi) { return (r & 3) + 8 * (r >> 2) + 4 * hi; }
template <int NS, int KSTR>
__device__ __forceinline__ void qk_tile(LAS unsigned char* lds, const bf16x8* qf, f32x16& p0, f32x16& p1, int r32, int hi) {
    const LAS unsigned char* kb = lds + A_K + r32 * KSTR + 16 * hi;
#pragma unroll
    for (int s = 0; s < NS; ++s) {
        const bf16x8 a0 = *(const LAS bf16x8*)(kb + 32 * s), a1 = *(const LAS bf16x8*)(kb + 32 * KSTR + 32 * s);
        p0 = __builtin_amdgcn_mfma_f32_32x32x16_bf16(a0, qf[s], p0, 0, 0, 0);
        p1 = __builtin_amdgcn_mfma_f32_32x32x16_bf16(a1, qf[s], p1, 0, 0, 0); }
}
__device__ __forceinline__ bf16x8 pack8(const f32x16& p, int base) {
    u32x4 w; w.x = pk2(p[base + 0], p[base + 1]); w.y = pk2(p[base + 2], p[base + 3]); w.z = pk2(p[base + 4], p[base + 5]); w.w = pk2(p[base + 6], p[base + 7]);
    return __builtin_bit_cast(bf16x8, w);
}
__device__ __forceinline__ void pv_tile(LAS unsigned char* lds, const f32x16& p0, const f32x16& p1, f32x16& o0, f32x16& o1, int r32, int hi) {
    const LAS unsigned char* vb = lds + A_V + r32 * A_VSTR + 8 * hi;
#pragma unroll
    for (int s = 0; s < 4; ++s) {
        const bf16x8 pb = (s < 2) ? pack8(p0, 8 * s) : pack8(p1, 8 * (s - 2));
        const s16x4 a0l = *(const LAS s16x4*)(vb + 32 * s), a0h = *(const LAS s16x4*)(vb + 32 * s + 16);
        const s16x4 a1l = *(const LAS s16x4*)(vb + 32 * A_VSTR + 32 * s), a1h = *(const LAS s16x4*)(vb + 32 * A_VSTR + 32 * s + 16);
        const bf16x8 va0 = (bf16x8){a0l[0], a0l[1], a0l[2], a0l[3], a0h[0], a0h[1], a0h[2], a0h[3]};
        const bf16x8 va1 = (bf16x8){a1l[0], a1l[1], a1l[2], a1l[3], a1h[0], a1h[1], a1h[2], a1h[3]};
        o0 = __builtin_amdgcn_mfma_f32_32x32x16_bf16(va0, pb, o0, 0, 0, 0);
        o1 = __builtin_amdgcn_mfma_f32_32x32x16_bf16(va1, pb, o1, 0, 0, 0); }
}
__device__ __forceinline__ void store_o(bf16_t* orow, const f32x16& o0, const f32x16& o1, float inv, int hi) {
#pragma unroll
    for (int g = 0; g < 4; ++g) {
        u32x2 w0, w1; w0.x = pk2(o0[4 * g] * inv, o0[4 * g + 1] * inv); w0.y = pk2(o0[4 * g + 2] * inv, o0[4 * g + 3] * inv);
        w1.x = pk2(o1[4 * g] * inv, o1[4 * g + 1] * inv); w1.y = pk2(o1[4 * g + 2] * inv, o1[4 * g + 3] * inv);
        *(u32x2*)(orow + 8 * g + 4 * hi) = w0; *(u32x2*)(orow + 32 + 8 * g + 4 * hi) = w1; }
}
__device__ __forceinline__ float max3f(float a, float b, float c) { float r; asm("v_max3_f32 %0, %1, %2, %3" : "=v"(r) : "v"(a), "v"(b), "v"(c)); return r; }
__device__ __forceinline__ float max32(const f32x16& p0, const f32x16& p1) {
    float a = max3f(p0[0], p0[1], p1[0]), b = max3f(p0[2], p0[3], p1[1]); a = max3f(a, p1[2], p1[3]);
#pragma unroll
    for (int r = 4; r < 16; r += 4) { a = max3f(a, p0[r], p0[r + 1]); b = max3f(b, p0[r + 2], p0[r + 3]); a = max3f(a, p1[r], p1[r + 1]); b = max3f(b, p1[r + 2], p1[r + 3]); }
    a = fmaxf(a, b);
    float x0 = a, x1 = a;
    asm volatile("s_nop 1\n\tv_permlane32_swap_b32 %0, %1" : "+v"(x0), "+v"(x1));
    return fmaxf(x0, x1);
}
__device__ __forceinline__ int t5_bucket(int d) {
    if (d < 16) return d;
    const int v = 16 + (int)(logf((float)d * (1.f / 16.f)) * (16.0f / 2.0794415416798357f));
    return v < 31 ? v : 31;
}
__device__ __forceinline__ void load_bias_table(Frame& F, const float* rel_bias, int hoff) {
    LAS float* tb = (LAS float*)(F.lds + A_TB);
    for (int e = F.tid; e < 8 * 129; e += 512) { const int h = e / 129, i = e % 129; tb[h * A_TBSTR + i] = rel_bias[t5_bucket(i) * 16 + hoff + h] * LOG2E; }
    __syncthreads();
}

struct AttnArgs {
    const bf16_t* Q; int qpitch, qcol;
    const bf16_t* K; int kpitch, kcol;
    const bf16_t* Kr;
    const bf16_t* VT;
    const float* fc;
    bf16_t* O; int opitch, ocol;
    const float* sinks;
    const float* kt; const float* qt;
};
template <int MODE>
__device__ __forceinline__ void attn_unit(Frame& F, const AttnArgs& a, int b, int hg, int qb) {
    constexpr bool DENSE = MODE < 2;
    constexpr int DK = MODE == 0 ? 96 : 64, NS = DK / 16, KSTR = MODE == 0 ? A_KSTR96 : A_KSTR64, W = MODE == 2 ? 256 : (MODE == 3 ? 128 : (1 << 30));
    LAS unsigned char* lds = F.lds;
    const int tid = F.tid, lane = F.lane, wid = F.wave, r32 = lane & 31, hi = lane >> 5;
    const int q0 = DENSE ? qb * 256 : qb * 64, qw0 = DENSE ? q0 + 32 * wid : q0 + 8 * wid, qw1 = DENSE ? qw0 + 31 : qw0 + 7;
    const int q = DENSE ? qw0 + r32 : qw0 + (r32 & 7), head = DENSE ? hg : 4 * hg + (r32 >> 3);
    int t_lo = (DENSE || MODE == 4) ? 0 : ((q0 - W + 1) > 0 ? (q0 - W + 1) >> 6 : 0); const int t_hi = DENSE ? 4 * qb + 3 : qb;
    if constexpr (MODE == 1) {
        float km = 0.f;
        if (lane <= t_hi) km = a.kt[lane];
        if (lane + 64 <= t_hi) km = fmaxf(km, a.kt[lane + 64]);
        km = wave_max(km);
        const float qm = fmaxf(fmaxf(a.qt[4 * qb], a.qt[4 * qb + 1]), fmaxf(a.qt[4 * qb + 2], a.qt[4 * qb + 3]));
        const float thr = -(48.0f + 2.02f * qm * km), f0 = a.fc[q0];
        const int n_int = 4 * qb;
        const bool s0 = lane < n_int && (f0 - a.fc[64 * lane + 63]) < thr, s1 = lane + 64 < n_int && (f0 - a.fc[64 * (lane + 64) + 63]) < thr;
        t_lo = __popcll(__ballot(s0)) + __popcll(__ballot(s1));
    }
    const LAS unsigned* selm = (const LAS unsigned*)(lds + A_SEL) + (wid * 8 + (r32 & 7)) * 4;
    bf16x8 qf[NS];
    { const bf16_t* qp = a.Q + (size_t)(b * SEQ + q) * a.qpitch + a.qcol + head * DK + 8 * hi;
#pragma unroll
      for (int s = 0; s < NS; ++s) qf[s] = *(const bf16x8*)(qp + 16 * s); }
    if constexpr (MODE == 0) {
        bf16x8 x1 = qf[4], x2 = qf[5];
#pragma unroll
        for (int j = 0; j < 8; ++j) { float sn, cs; rope_sincos(q, 8 * hi + j, sn, cs);
            const float u = bf2f((unsigned short)x1[j]), v = bf2f((unsigned short)x2[j]);
            x1[j] = (short)f2bf(u * cs - v * sn); x2[j] = (short)f2bf(u * sn + v * cs); }
        qf[4] = x1; qf[5] = x2; }
    const int srow = tid >> 3, sch = tid & 7;
    const bf16_t* kp = a.K + (size_t)(b * SEQ + srow) * a.kpitch + a.kcol + 8 * sch;
    const bf16_t* krp = (MODE == 0) ? a.Kr + (size_t)(b * SEQ + (tid >> 2)) * 32 + 8 * (tid & 3) : nullptr;
    const bf16_t* vp = a.VT + (size_t)srow * MTOK + b * SEQ + 8 * sch;
    constexpr int U_K = 0, U_KS = 64 * A_KSTR96, U_V = 2 * U_KS, U_VS = 64 * A_VSTR, U_FK = U_V + 2 * U_VS;
    LAS unsigned char* kd = lds + U_K + srow * KSTR + 16 * sch;
    LAS unsigned char* krd = lds + U_K + (tid >> 2) * KSTR + 128 + 16 * (tid & 3);
    LAS unsigned char* vd = lds + U_V + srow * A_VSTR + 16 * sch;
    u32x4 rkA, rkrA = (u32x4){0u, 0u, 0u, 0u}, rvA, rkB, rkrB = (u32x4){0u, 0u, 0u, 0u}, rvB; float rfA = 0.f, rfB = 0.f;
#define TT(t) (MODE == 1 ? (t_lo + t_hi - (t)) : (t))
#define ATT_LOAD(R, t) do { const int tl_ = TT(t); rk##R = *(const u32x4*)(kp + (size_t)tl_ * 64 * a.kpitch); rv##R = *(const u32x4*)(vp + tl_ * 64); \
        if (MODE == 0) { if (tid < 256) rkr##R = *(const u32x4*)(krp + (size_t)tl_ * 64 * 32); } \
        if (MODE == 1) { if (tid < 64) rf##R = a.fc[tl_ * 64 + tid]; } } while (0)
#define ATT_WRITE(R, S) do { *(LAS u32x4*)(kd + (S) * U_KS) = rk##R; *(LAS u32x2*)(vd + (S) * U_VS) = (u32x2){rv##R.x, rv##R.y}; *(LAS u32x2*)(vd + (S) * U_VS + 8) = (u32x2){rv##R.z, rv##R.w}; \
        if (MODE == 0) { if (tid < 256) *(LAS u32x4*)(krd + (S) * U_KS) = rkr##R; } \
        if (MODE == 1) { if (tid < 64) ((LAS float*)(lds + U_FK + (S) * 256))[tid] = rf##R; } } while (0)
    f32x16 o0, o1;
#pragma unroll
    for (int i = 0; i < 16; ++i) { o0[i] = 0.f; o1[i] = 0.f; }
    float m = NEGF, l = 0.f;
    if constexpr (MODE == 3) { m = a.sinks[head] * LOG2E; l = hi == 0 ? 1.f : 0.f; }
#define ATT_COMPUTE(tt, S) do { const int t_ = TT(tt); const int kv0 = 64 * t_; \
        bool selbit = true; \
        if constexpr (MODE == 4) selbit = ((selm[t_ >> 5] >> (t_ & 31)) & 1u) != 0u; \
        const bool active = DENSE ? (kv0 <= qw1) : (MODE == 4 ? (__any(selbit) != 0) : (kv0 <= qw1 && kv0 + 63 >= qw0 - W + 1)); \
        if (active) { \
            f32x16 p0, p1; const float nm = (m == NEGF) ? 0.f : -m;     \
            if constexpr (MODE == 1) { \
                const LAS float* fk = (const LAS float*)(lds + U_FK + (S) * 256); \
                _Pragma("unroll") for (int g = 0; g < 4; ++g) { const f32x4 x0 = *(const LAS f32x4*)(fk + 8 * g + 4 * hi), x1 = *(const LAS f32x4*)(fk + 32 + 8 * g + 4 * hi); \
                    _Pragma("unroll") for (int i = 0; i < 4; ++i) { p0[4 * g + i] = nm - x0[i]; p1[4 * g + i] = nm - x1[i]; } } \
            } else { \
                _Pragma("unroll") for (int i = 0; i < 16; ++i) { p0[i] = nm; p1[i] = nm; } \
            } \
            qk_tile<NS, KSTR>(lds + U_K + (S) * U_KS - A_K, qf, p0, p1, r32, hi); \
            if constexpr (DENSE) { \
                if (kv0 + 63 > qw0) { \
                    _Pragma("unroll") for (int r = 0; r < 16; ++r) { const int kv = kv0 + crow(r, hi); if (kv > q) p0[r] = NEGF; if (kv + 32 > q) p1[r] = NEGF; } } \
            } else { \
                const LAS float* tb = (const LAS float*)(lds + A_TB) + (head & 7) * A_TBSTR; \
                _Pragma("unroll") for (int r = 0; r < 16; ++r) { const int d0 = q - (kv0 + crow(r, hi)), d1 = d0 - 32; \
                    const int i0 = d0 < 0 ? 0 : (d0 > 128 ? 128 : d0), i1 = d1 < 0 ? 0 : (d1 > 128 ? 128 : d1); \
                    p0[r] = (d0 >= 0 && d0 < W && selbit) ? p0[r] + tb[i0] : NEGF; p1[r] = (d1 >= 0 && d1 < W && selbit) ? p1[r] + tb[i1] : NEGF; } \
            } \
              \
            const bool expfirst = MODE != 1 && !__any(m == NEGF); \
            bool keep = true; \
            if (!expfirst) { \
                const float mx = max32(p0, p1);                  \
                const bool unset = (m == NEGF), seen = mx > -1e29f; \
                  \
                if (MODE == 1) keep = __any(unset || mx > -38.0f); \
                if (keep && __any(unset ? seen : (mx > 8.0f))) { const float dm = unset ? (seen ? mx : 0.f) : fmaxf(mx, 0.f), alpha = unset ? 1.f : fexp2(-dm); m = unset ? (seen ? mx : NEGF) : m + dm; l *= alpha; \
                    _Pragma("unroll") for (int r = 0; r < 16; ++r) { o0[r] *= alpha; o1[r] *= alpha; p0[r] -= dm; p1[r] -= dm; } } \
            } \
            if (keep) { \
                float rs = 0.f; \
                _Pragma("unroll") for (int r = 0; r < 16; ++r) { p0[r] = fexp2(p0[r]); p1[r] = fexp2(p1[r]); rs += p0[r] + p1[r]; } \
                if (expfirst && __any(rs > 4096.0f)) { const float dm = fmaxf(__log2f(max32(p0, p1)), 0.f), alpha = fexp2(-dm); m += dm; l *= alpha; rs *= alpha; \
                    _Pragma("unroll") for (int r = 0; r < 16; ++r) { o0[r] *= alpha; o1[r] *= alpha; p0[r] *= alpha; p1[r] *= alpha; } } \
                l += rs; \
                pv_tile(lds + U_V + (S) * U_VS - A_V, p0, p1, o0, o1, r32, hi); } \
        } } while (0)
    ATT_LOAD(A, t_lo);
    if (t_lo < t_hi) ATT_LOAD(B, t_lo + 1);
    __syncthreads();
    ATT_WRITE(A, 0);
    if (t_lo + 2 <= t_hi) ATT_LOAD(A, t_lo + 2);
    __syncthreads();
    for (int t = t_lo; ; t += 2) {
        if (t + 1 <= t_hi) { ATT_WRITE(B, 1); if (t + 3 <= t_hi) ATT_LOAD(B, t + 3); }
        ATT_COMPUTE(t, 0);
        if (t + 1 > t_hi) break;
        __syncthreads();
        if (t + 2 <= t_hi) { ATT_WRITE(A, 0); if (t + 4 <= t_hi) ATT_LOAD(A, t + 4); }
        ATT_COMPUTE(t + 1, 1);
        if (t + 2 > t_hi) break;
        __syncthreads();
    }
    const float lt = l + __shfl_xor(l, 32), inv = 1.0f / lt;
    store_o(a.O + (size_t)(b * SEQ + q) * a.opitch + a.ocol + head * 64, o0, o1, inv, hi);
    __syncthreads();
#undef ATT_COMPUTE
#undef TT
#undef ATT_LOAD
#undef ATT_WRITE
}

__device__ __forceinline__ void nsa_unit(Frame& F, int b, int g, int qblk, const bf16_t* P, const bf16_t* kcmp, const bf16_t* vcmpt, const bf16_t* VTsel, bf16_t* OC, bf16_t* OS) {
    LAS unsigned char* lds = F.lds;
    const int tid = F.tid, lane = F.lane, wid = F.wave, r32 = lane & 31, hi = lane >> 5;
    const int q0 = qblk * 64, qw0 = q0 + 8 * wid, q = qw0 + (r32 >> 2), rr = r32 & 3, head = 4 * g + rr, cur = qblk;
    const int ntile = (((q0 + 32) >> 4) >> 6) + 1;
    const bf16_t* kc = kcmp + (size_t)(b * 2 + g) * 512 * 64; const bf16_t* vct = vcmpt + (size_t)(b * 2 + g) * 64 * 512;
    bf16x8 qf[4];
    { const bf16_t* qp = P + (size_t)(b * SEQ + q) * PN + PC_NQ + head * 64 + 8 * hi;
#pragma unroll
      for (int s = 0; s < 4; ++s) qf[s] = *(const bf16x8*)(qp + 16 * s); }
    const int srow = tid >> 3, sch = tid & 7;
    const bf16_t* kp = kc + (size_t)srow * 64 + 8 * sch; const bf16_t* vp = vct + (size_t)srow * 512 + 8 * sch;
    LAS unsigned char* kd = lds + N_K0 + srow * A_KSTR64 + 16 * sch; LAS unsigned char* vd = lds + N_V0 + srow * A_VSTR + 16 * sch;
    const LAS float* tb = (const LAS float*)(lds + A_TB) + head * A_TBSTR;
    u32x4 rk, rv;
    LAS float* impG = (LAS float*)(lds + A_IMP + wid * 8192); LAS float* impE = impG + 1024;
    for (int rep5 = 0; rep5 < DUPN(5); ++rep5) {
    float m = 0.f, l = 0.f;
    rk = *(const u32x4*)kp;
    __syncthreads();
    *(LAS u32x4*)kd = rk;
    if (1 < ntile) rk = *(const u32x4*)(kp + (size_t)64 * 64);
    __syncthreads();
    for (int t = 0; t < ntile; ++t) {
        if (t + 1 < ntile) { *(LAS u32x4*)(kd + ((t + 1) & 1) * N_KS) = rk; if (t + 2 < ntile) rk = *(const u32x4*)(kp + (size_t)(t + 2) * 64 * 64); }
        if (1024 * t + 24 <= qw0) {
            const bool far = 1024 * t + 1039 + 128 <= qw0;
            const float ini = far ? tb[128] - m : -m;
            f32x16 p0, p1;
#pragma unroll
            for (int i = 0; i < 16; ++i) { p0[i] = ini; p1[i] = ini; }
            qk_tile<4, A_KSTR64>(lds + N_K0 + (t & 1) * N_KS - A_K, qf, p0, p1, r32, hi);
            if (!far) {
#pragma unroll
            for (int r = 0; r < 16; ++r) { const int d0 = q - (16 * (64 * t + crow(r, hi)) + 31), d1 = d0 - 512;
                const int i0 = d0 < 0 ? 0 : (d0 > 128 ? 128 : d0), i1 = d1 < 0 ? 0 : (d1 > 128 ? 128 : d1);
                p0[r] = d0 >= 0 ? p0[r] + tb[i0] : NEGF; p1[r] = d1 >= 0 ? p1[r] + tb[i1] : NEGF; }
            }
            float rs = 0.f;
#pragma unroll
            for (int r = 0; r < 16; ++r) { p0[r] = fexp2(p0[r]); p1[r] = fexp2(p1[r]); rs += p0[r] + p1[r]; }
            if (__any(rs > 4096.0f)) { const float dm = fmaxf(__log2f(max32(p0, p1)), 0.f), alpha = fexp2(-dm); m += dm; l *= alpha; rs *= alpha; }
            l += rs;
        }
        __syncthreads();
    }
    const float invl = 1.0f / (l + __shfl_xor(l, 32));
    f32x16 o0, o1;
#pragma unroll
    for (int i = 0; i < 16; ++i) { o0[i] = 0.f; o1[i] = 0.f; }
    rk = *(const u32x4*)kp; rv = *(const u32x4*)vp;
    *(LAS u32x4*)kd = rk; *(LAS u32x2*)vd = (u32x2){rv.x, rv.y}; *(LAS u32x2*)(vd + 8) = (u32x2){rv.z, rv.w};
    if (1 < ntile) { rk = *(const u32x4*)(kp + (size_t)64 * 64); rv = *(const u32x4*)(vp + 64); }
    __syncthreads();
    for (int t = 0; t < ntile; ++t) {
        if (t + 1 < ntile) { const int s1 = (t + 1) & 1; *(LAS u32x4*)(kd + s1 * N_KS) = rk; *(LAS u32x2*)(vd + s1 * N_VS) = (u32x2){rv.x, rv.y}; *(LAS u32x2*)(vd + s1 * N_VS + 8) = (u32x2){rv.z, rv.w};
            if (t + 2 < ntile) { rk = *(const u32x4*)(kp + (size_t)(t + 2) * 64 * 64); rv = *(const u32x4*)(vp + (t + 2) * 64); } }
        if (1024 * t + 24 <= qw0) {
            const bool far = 1024 * t + 1039 + 128 <= qw0;
            const float ini = far ? tb[128] - m : -m;
            f32x16 p0, p1;
#pragma unroll
            for (int i = 0; i < 16; ++i) { p0[i] = ini; p1[i] = ini; }
            qk_tile<4, A_KSTR64>(lds + N_K0 + (t & 1) * N_KS - A_K, qf, p0, p1, r32, hi);
            if (far) {
#pragma unroll
                for (int r = 0; r < 16; ++r) { p0[r] = fexp2(p0[r]) * invl; p1[r] = fexp2(p1[r]) * invl; }
            } else {
#pragma unroll
            for (int r = 0; r < 16; ++r) { const int d0 = q - (16 * (64 * t + crow(r, hi)) + 31), d1 = d0 - 512;
                const int i0 = d0 < 0 ? 0 : (d0 > 128 ? 128 : d0), i1 = d1 < 0 ? 0 : (d1 > 128 ? 128 : d1);
                p0[r] = d0 >= 0 ? fexp2(p0[r] + tb[i0]) * invl : 0.f; p1[r] = d1 >= 0 ? fexp2(p1[r] + tb[i1]) * invl : 0.f; }
            }
            float gs[8], es[8];
#pragma unroll
            for (int g4 = 0; g4 < 4; ++g4) { gs[g4] = (p0[4 * g4] + p0[4 * g4 + 1]) + (p0[4 * g4 + 2] + p0[4 * g4 + 3]); es[g4] = p0[4 * g4 + 3];
                gs[4 + g4] = (p1[4 * g4] + p1[4 * g4 + 1]) + (p1[4 * g4 + 2] + p1[4 * g4 + 3]); es[4 + g4] = p1[4 * g4 + 3]; }
#pragma unroll
            for (int i = 0; i < 8; ++i) { gs[i] += dpp_f<0xB1>(gs[i]); gs[i] += dpp_f<0x4E>(gs[i]); es[i] += dpp_f<0xB1>(es[i]); es[i] += dpp_f<0x4E>(es[i]); }
            if (rr == 0) { const int qs = r32 >> 2;
#pragma unroll
                for (int g4 = 0; g4 < 4; ++g4) { const int s0 = 16 * t + 2 * g4 + hi;
                    impG[qs * 128 + s0] = gs[g4]; impG[qs * 128 + s0 + 8] = gs[4 + g4]; impE[qs * 128 + s0] = es[g4]; impE[qs * 128 + s0 + 8] = es[4 + g4]; } }
            pv_tile(lds + N_V0 + (t & 1) * N_VS - A_V, p0, p1, o0, o1, r32, hi);
        }
        __syncthreads();
    }
    store_o(OC + (size_t)(b * SEQ + q) * 512 + head * 64, o0, o1, 1.0f, hi);
    }
    LDS_FENCE();
    LAS unsigned* selmw = (LAS unsigned*)(lds + A_SEL) + wid * 32;
#pragma unroll 1
    for (int bq = 0; bq < 2; ++bq) {
        const int qi = 4 * bq + (lane >> 4), l16 = lane & 15;
        const LAS float* G = impG + qi * 128; const LAS float* E = impE + qi * 128;
        const int chi = cur - 2;
        float v[8];
#pragma unroll
        for (int k = 0; k < 8; ++k) { const int s = l16 + 16 * k; v[k] = (s >= 1 && s <= chi) ? G[s] + E[s - 1] : -1.f; }
        unsigned mw[4] = {1u, 0u, 0u, 0u};
#define SETBIT(j) do { const int _j = (j); const unsigned _b = 1u << (_j & 31); const int _w = _j >> 5; mw[0] |= _w == 0 ? _b : 0u; mw[1] |= _w == 1 ? _b : 0u; mw[2] |= _w == 2 ? _b : 0u; mw[3] |= _w == 3 ? _b : 0u; } while (0)
        SETBIT(cur); if (cur >= 1) SETBIT(cur - 1);
#pragma unroll 1
        for (int rnd = 0; rnd < 5; ++rnd) {
            float bv = v[0]; int bi = l16;
#pragma unroll
            for (int k = 1; k < 8; ++k) { if (v[k] > bv) { bv = v[k]; bi = l16 + 16 * k; } }
#define TOPK_STEP(CTRL) do { const float ov = dpp_f<CTRL>(bv); const int oi = dpp_i<CTRL>(bi); if (ov > bv || (ov == bv && oi < bi)) { bv = ov; bi = oi; } } while (0)
            TOPK_STEP(0x128); TOPK_STEP(0x124); TOPK_STEP(0x122); TOPK_STEP(0x121);
#undef TOPK_STEP
            if (bv >= 0.f) SETBIT(bi);
#pragma unroll
            for (int k = 0; k < 8; ++k) { if (bi == l16 + 16 * k) v[k] = -1.f; }
        }
#undef SETBIT
        if (l16 == 0) { selmw[qi * 4 + 0] = mw[0]; selmw[qi * 4 + 1] = mw[1]; selmw[qi * 4 + 2] = mw[2]; selmw[qi * 4 + 3] = mw[3]; }
    }
    LDS_FENCE();
    __syncthreads();
    for (int rep4 = 0; rep4 < DUPN(4); ++rep4) {
        LAS unsigned* wmw = (LAS unsigned*)(lds + A_WM) + wid * 4;
        if (lane < 4) { unsigned x = 0u;
#pragma unroll
            for (int qi = 0; qi < 8; ++qi) x |= selmw[qi * 4 + lane];
            wmw[lane] = x; }
        LDS_FENCE();
        const LAS unsigned* selm = (const LAS unsigned*)selmw + (r32 >> 2) * 4;
        LAS unsigned char* kw = lds + wid * SW_BYTES; LAS unsigned char* vw = kw + 64 * A_KSTR64;
        const LAS float* tbh = (const LAS float*)(lds + A_TB) + head * A_TBSTR;
        const float bias_far = tbh[128];
        const bf16_t* kg = P + ((size_t)b * SEQ + (lane >> 3)) * PN + PC_KS + g * 64 + 8 * (lane & 7);
        const bf16_t* vg = VTsel + (size_t)(g * 64 + (lane >> 3)) * MTOK + (size_t)b * SEQ + 8 * (lane & 7);
        LAS unsigned char* kdst = kw + (lane >> 3) * A_KSTR64 + 16 * (lane & 7); LAS unsigned char* vdst = vw + (lane >> 3) * A_VSTR + 16 * (lane & 7);
        f32x16 o0, o1;
#pragma unroll
        for (int i = 0; i < 16; ++i) { o0[i] = 0.f; o1[i] = 0.f; }
        float m = 0.f, l = 0.f;
        int w = 0; unsigned cw = __builtin_amdgcn_readfirstlane(wmw[0]);
        int j = __builtin_ctz(cw); cw &= cw - 1u;
        u32x4 rk[8], rv[8];
#define SELW_LOAD(jj) do { _Pragma("unroll") for (int i = 0; i < 8; ++i) { rk[i] = *(const u32x4*)(kg + (size_t)(64 * (jj) + 8 * i) * PN); rv[i] = *(const u32x4*)(vg + (size_t)(8 * i) * MTOK + 64 * (jj)); } } while (0)
        SELW_LOAD(j);
        for (;;) {
#pragma unroll
            for (int i = 0; i < 8; ++i) { *(LAS u32x4*)(kdst + 8 * i * A_KSTR64) = rk[i];
                *(LAS u32x2*)(vdst + 8 * i * A_VSTR) = (u32x2){rv[i].x, rv[i].y}; *(LAS u32x2*)(vdst + 8 * i * A_VSTR + 8) = (u32x2){rv[i].z, rv[i].w}; }
            while (cw == 0u && w < 3) { ++w; cw = __builtin_amdgcn_readfirstlane(wmw[w]); }
            const bool more = cw != 0u; int jn = j;
            if (more) { jn = 32 * w + __builtin_ctz(cw); cw &= cw - 1u; SELW_LOAD(jn); }
            {
                const int kv0 = 64 * j;
                const bool selbit = ((selm[j >> 5] >> (j & 31)) & 1u) != 0u;
                const bool far = kv0 + 63 + 128 <= qw0;
                const float ini = far ? (selbit ? bias_far - m : NEGF) : -m;
                f32x16 p0, p1;
#pragma unroll
                for (int i = 0; i < 16; ++i) { p0[i] = ini; p1[i] = ini; }
                qk_tile<4, A_KSTR64>(kw - A_K, qf, p0, p1, r32, hi);
                if (!far) {
#pragma unroll
                    for (int r = 0; r < 16; ++r) { const int d0 = q - (kv0 + crow(r, hi)), d1 = d0 - 32;
                        const int i0 = d0 < 0 ? 0 : (d0 > 128 ? 128 : d0), i1 = d1 < 0 ? 0 : (d1 > 128 ? 128 : d1);
                        p0[r] = (d0 >= 0 && selbit) ? p0[r] + tbh[i0] : NEGF; p1[r] = (d1 >= 0 && selbit) ? p1[r] + tbh[i1] : NEGF; }
                }
                const float mx = max32(p0, p1);
                if (__any(mx > 8.0f)) { const float dm = fmaxf(mx, 0.f), alpha = fexp2(-dm); m += dm; l *= alpha;
#pragma unroll
                    for (int r = 0; r < 16; ++r) { o0[r] *= alpha; o1[r] *= alpha; p0[r] -= dm; p1[r] -= dm; } }
                float rs = 0.f;
#pragma unroll
                for (int r = 0; r < 16; ++r) { p0[r] = fexp2(p0[r]); p1[r] = fexp2(p1[r]); rs += p0[r] + p1[r]; }
                l += rs;
                pv_tile(vw - A_V, p0, p1, o0, o1, r32, hi);
            }
            if (!more) break;
            j = jn;
        }
#undef SELW_LOAD
        const float lt = l + __shfl_xor(l, 32), inv = 1.0f / lt;
        store_o(OS + (size_t)(b * SEQ + q) * 512 + head * 64, o0, o1, inv, hi);
    }
    __syncthreads();
}

__device__ __forceinline__ int fox_head_of_rank(const float* bf, int rho) {
    float v[8];
#pragma unroll
    for (int i = 0; i < 8; ++i) v[i] = bf[i];
    int res = 0;
#pragma unroll
    for (int h = 0; h < 8; ++h) { int rk = 0;
#pragma unroll
        for (int g = 0; g < 8; ++g) rk += (v[g] < v[h] || (v[g] == v[h] && g < h)) ? 1 : 0;
        if (rk == rho) res = h; }
    return res;
}
__device__ const unsigned char SCHED[3][32][4] = {
    {{0,63,95,127},{31,32,94,126},{30,62,64,125},{29,61,93,96},{1,38,92,124},{6,33,91,123},{28,60,65,102},{27,59,70,97},{2,37,90,122},{5,34,89,121},{26,58,66,101},{25,57,69,98},{3,36,88,120},{4,35,87,119},{24,56,67,100},{23,55,68,99},{22,54,86,118},{21,53,85,117},{20,52,84,116},{19,51,83,115},{18,50,82,114},{17,49,81,113},{16,48,80,112},{15,47,79,111},{14,46,78,110},{13,45,77,109},{12,44,76,108},{11,43,75,107},{10,42,74,106},{9,41,73,105},{8,40,72,104},{7,39,71,103}},
    {{51,49,32,14},{66,60,33,12},{80,52,34,9},{111,55,35,6},{104,67,43,4},{100,88,37,2},{95,94,38,1},{107,79,48,0},{78,69,40,10},{116,64,42,7},{102,73,44,5},{120,103,36,3},{91,41,39,15},{75,53,45,13},{85,50,46,11},{122,54,47,8},{113,83,63,31},{125,81,62,30},{127,82,61,29},{124,84,65,28},{121,90,59,27},{99,98,58,26},{123,109,57,24},{118,96,56,25},{119,92,68,23},{108,89,76,21},{126,110,74,16},{105,101,70,22},{117,115,71,19},{114,93,77,18},{106,87,86,17},{112,97,72,20}},
    {{31,48,79,255},{16,63,255,111},{15,255,95,112},{255,47,80,127},{30,49,78,255},{17,62,255,110},{14,255,94,113},{255,46,81,126},{29,50,77,255},{18,61,255,109},{13,255,93,114},{255,45,82,125},{28,51,76,255},{19,60,255,108},{12,255,92,115},{255,44,83,124},{27,52,255,255},{20,59,255,255},{255,255,91,116},{255,255,84,123},{26,53,255,255},{21,58,255,255},{255,255,90,117},{255,255,85,122},{25,54,255,255},{22,57,255,255},{255,255,89,118},{255,255,86,121},{24,55,255,255},{23,56,255,255},{255,255,88,119},{255,255,87,120}}};
constexpr int MLA_POOL_QB = 12;
constexpr int QW_BASE = 4096;

constexpr int PH_PER_LAYER = 5 + 2 * N_CHUNK, NPHASE = 1 + DEPTH * PH_PER_LAYER + 1;
struct Args { const float* in[19]; float* out; unsigned char* ws; int ph_lo, ph_hi; };

__global__ void __launch_bounds__(512, 2) fwd_kernel(Args args) {
    extern __shared__ __attribute__((aligned(16))) unsigned char lds_raw[];
    Frame F;
    F.lds = (LAS unsigned char*)lds_raw;
    const int wave_s = __builtin_amdgcn_readfirstlane(threadIdx.x >> 6);
    F.tid = threadIdx.x; F.lane = F.tid & 63; F.wave = wave_s;
    F.G = gridDim.x; F.c = blockIdx.x;
#pragma unroll
    for (int i = 0; i < 19; ++i) F.in[i] = args.in[i];
    F.out = args.out; F.ws = args.ws;
    volatile LAS unsigned* misc = (volatile LAS unsigned*)(F.lds + LDSCTL_OFF);
    if (F.tid < 64) misc[F.tid] = 0u;
    __syncthreads();
    const int lo = args.ph_lo, hi = args.ph_hi;
    XcdBarrier bar; bar.bar = (unsigned*)(F.ws + WS_CTL); bar.x = 0; bar.st = misc + 8; bar.w0 = wave_s == 0;
    if (hi - lo > 1) bar = xcd_barrier_post((unsigned*)(F.ws + WS_CTL), misc + 8);
#define IN(k) (lo <= (k) && (k) < hi)
#define REFRESH() do { const int _l = lane_now(); F.lane = _l; F.wave = wave_s; F.tid = (wave_s << 6) | _l; } while (0)
#define SEAM(k) do { if (IN(k) && IN((k) + 1)) { for (int rep13 = 0; rep13 < DUPN(13); ++rep13) xcd_barrier(bar); } } while (0)
    unsigned char* ws = F.ws;
    bf16_t* ACT = (bf16_t*)(ws + WS_ACT); bf16_t* P = (bf16_t*)(ws + WS_P); bf16_t* HID = (bf16_t*)(ws + WS_P); bf16_t* VT = (bf16_t*)(ws + WS_VT);
    bf16_t* MQ = (bf16_t*)(ws + WS_MQ); bf16_t* MK = (bf16_t*)(ws + WS_MK); bf16_t* MVT = (bf16_t*)(ws + WS_MVT);
    bf16_t* OC = (bf16_t*)(ws + WS_OC); bf16_t* OS = (bf16_t*)(ws + WS_OS); bf16_t* OW = (bf16_t*)(ws + WS_OW);
    bf16_t* HB = (bf16_t*)(ws + WS_HB); float* SS = (float*)(ws + WS_SS);
    float* KT = (float*)(ws + WS_KT); bf16_t* KR = (bf16_t*)(ws + WS_KR); float* MSQ = (float*)(ws + WS_MSQ); float* MSKV = (float*)(ws + WS_MSKV);
    float* FC = (float*)(ws + WS_FC); bf16_t* KCMP = (bf16_t*)(ws + WS_KCMP); bf16_t* VCMPT = (bf16_t*)(ws + WS_VCMPT);
    const int gw = F.c * 8 + F.wave, NGW = F.G * 8;
    int pid = 0;
    if (IN(pid)) { for (int rep6 = 0; rep6 < DUPN(6); ++rep6) { REFRESH(); prologue(F); } }
    SEAM(pid); ++pid;
    for (int L = 0; L < DEPTH; ++L) {
        unsigned char* wl = ws + WS_W + (size_t)L * WL_SIZE;
        if (IN(pid)) { REFRESH();
            for (int rep12 = 0; rep12 < DUPN(12); ++rep12) {
            { pg8::Gemm g{HB, (const bf16_t*)(wl + WL_WIN), MTOK, PN, D_MODEL, D_MODEL, D_MODEL}; pg8::StaticOrder S; S.init(MTOK, PN, F.G, F.c);
              pg8::EpiBf16<0, 1, 8, true> E{P, PN, SS + (size_t)(2 * L) * MTOK * 32, 1.0f / 2048.0f, MSQ, MSKV}; pg8::gemm_phase(F.lds, g, S, E, F.tid); }
            REFRESH();
            { pg8::Gemm g{(const bf16_t*)(wl + WL_WINV), HB, VTN, MTOK, D_MODEL, D_MODEL, D_MODEL}; pg8::StaticOrder S; S.init(VTN, MTOK, F.G, F.c);
              pg8::EpiBf16<0, 2> E{VT, MTOK, SS + (size_t)(2 * L) * MTOK * 32, 1.0f / 2048.0f, nullptr, nullptr}; pg8::gemm_phase(F.lds, g, S, E, F.tid); }
            REFRESH(); }
        }
        SEAM(pid); ++pid;
        if (IN(pid)) { REFRESH();
            for (int rep11 = 0; rep11 < DUPN(11); ++rep11) {
            { pg8::Gemm g{P + PC_CQ, (const bf16_t*)(wl + WL_WUQ), MTOK, 768, 384, PN, 384}; pg8::StaticOrder S; S.init(MTOK, 768, F.G, F.c);
              pg8::EpiBf16<0, 1, 2> E{MQ, 768, MSQ, 1.0f / 384.0f, nullptr, nullptr}; pg8::gemm_phase(F.lds, g, S, E, F.tid); }
            REFRESH();
            { pg8::Gemm g{P + PC_CKV, (const bf16_t*)(wl + WL_WUKVK), MTOK, 512, 256, PN, 256}; pg8::StaticOrder S; S.init(MTOK, 512, F.G, F.c);
              pg8::EpiBf16<0, 1, 1> E{MK, 512, MSKV, 1.0f / 128.0f, nullptr, nullptr}; pg8::gemm_phase(F.lds, g, S, E, F.tid); }
            REFRESH();
            { pg8::Gemm g{(const bf16_t*)(wl + WL_WUKVV), P + PC_CKV, 512, MTOK, 256, 256, PN}; pg8::StaticOrder S; S.init(512, MTOK, F.G, F.c);
              pg8::EpiBf16<0, 2, 1> E{MVT, MTOK, MSKV, 1.0f / 128.0f, nullptr, nullptr}; pg8::gemm_phase(F.lds, g, S, E, F.tid); }
            REFRESH(); }
            __syncthreads();
            for (int m = 4 * gw; m < MTOK; m += 4 * NGW) krope_tokens(P, KR, m, F.lane);
            REFRESH();
            for (int rep9 = 0; rep9 < DUPN(9); ++rep9) {
            for (int s = F.c; s < BATCH * 8; s += F.G) fox_scan_seq(F, P, F.in[7] + L * 8, FC, s);
            REFRESH();
            for (int it = F.c; it < 256; it += F.G) nsa_compress_item(F, it, P, (const bf16_t*)(wl + WL_W1T), (const float*)(wl + WL_CB1), F.in[10] + (size_t)L * 2 * 64 * 64, KCMP, VCMPT);
            }
            REFRESH();
            for (int it = gw; it < BATCH * 8 * 128; it += NGW) fox_norm_tile(P, KT, KT + BATCH * 8 * 128, it, F.lane);
            __syncthreads(); REFRESH();
            load_bias_table(F, F.in[17], 8);
            for (int rep = 0; rep < DUPN(3); ++rep)
            for (int i = F.c; i < 1024; i += F.G) { const int bg = i & 7, qb = i >> 3, b = bg >> 1, g = bg & 1;
                AttnArgs a{P, PN, PC_SQ, P, PN, PC_SK + g * 64, nullptr, VT + (size_t)(VR_SV + g * 64) * MTOK, nullptr, ACT, D_MODEL, 1536, F.in[11] + L * 8, nullptr, nullptr};
                attn_unit<3>(F, a, b, g, qb); }
            __syncthreads(); REFRESH();
            load_bias_table(F, F.in[17], 0);
            for (int rep = 0; rep < DUPN(3); ++rep)
            for (int i = F.c; i < 1024; i += F.G) { const int bg = i & 7, qb = i >> 3, b = bg >> 1, g = bg & 1;
                AttnArgs a{P, PN, PC_NQ, P, PN, PC_KW + g * 64, nullptr, VT + (size_t)(VR_WV + g * 64) * MTOK, nullptr, OW, 512, 0, nullptr, nullptr, nullptr};
                attn_unit<2>(F, a, b, g, qb); }
            __syncthreads();
        }
        SEAM(pid); ++pid;
        if (IN(pid)) { REFRESH();
            for (int i = F.c; i < 1024; i += F.G) { const int s = i >> 8, vb = i & 255, x = vb & 7, u = SCHED[0][vb >> 3][s], qb = u & 31, b = u >> 5;
                const int h = fox_head_of_rank(F.in[7] + L * 8, b == 0 ? x : (b == 1 ? 7 - x : (b == 2 ? ((x + 4) & 7) : ((3 - x) & 7))));
                AttnArgs a{P, PN, PC_FQ, P, PN, PC_FK + h * 64, nullptr, VT + (size_t)(VR_FV + h * 64) * MTOK, FC + (size_t)(b * 8 + h) * SEQ, ACT, D_MODEL, 512, nullptr, KT + (size_t)(b * 8 + h) * 128, KT + (size_t)(BATCH * 8 + b * 8 + h) * 128};
                attn_unit<1>(F, a, b, h, qb); }
            __syncthreads(); REFRESH();
            load_bias_table(F, F.in[17], 0);
            for (int i = F.c; i < 1024; i += F.G) { const int s = i >> 8, vb = i & 255, bg = vb & 7, b = bg >> 1, g = bg & 1;
                nsa_unit(F, b, g, SCHED[1][vb >> 3][s], P, KCMP, VCMPT, VT + (size_t)VR_VS * MTOK, OC, OS); }
            __syncthreads(); REFRESH();
            for (int i = F.c; i < 1024; i += F.G) { const int s = i >> 8, vb = i & 255, u = SCHED[2][vb >> 3][s], qb = u & 31, bh = (vb & 7) + 8 * (u >> 5), b = bh >> 3, h = bh & 7;
                if (u == 255) continue;
                AttnArgs a{MQ, 768, 0, MK, 512, h * 64, KR, MVT + (size_t)(h * 64) * MTOK, nullptr, ACT, D_MODEL, 0, nullptr, nullptr, nullptr};
                attn_unit<0>(F, a, b, h, qb); }
            { unsigned* ctr = (unsigned*)(F.ws + WS_CTL) + QW_BASE + 64 * L; volatile LAS int* qs = (volatile LAS int*)(F.lds + LDSCTL_OFF + 512);
              for (;;) { __syncthreads(); if (F.tid == 0) *qs = (int)__hip_atomic_fetch_add(ctr, 1u, __ATOMIC_RELAXED, __HIP_MEMORY_SCOPE_AGENT); __syncthreads();
                const int i = __builtin_amdgcn_readfirstlane(*qs); if (i >= 32 * MLA_POOL_QB) break;
                const int qb = MLA_POOL_QB - 1 - (i >> 5), bh = i & 31, b = bh >> 3, h = bh & 7;
                AttnArgs a{MQ, 768, 0, MK, 512, h * 64, KR, MVT + (size_t)(h * 64) * MTOK, nullptr, ACT, D_MODEL, 0, nullptr, nullptr, nullptr};
                attn_unit<0>(F, a, b, h, qb); } }
            __syncthreads();
        }
        SEAM(pid); ++pid;
        if (IN(pid)) { REFRESH();
            for (int m = gw; m < MTOK; m += 2 * NGW) { if (m + NGW < MTOK) combine_norm_tokens<2>(ACT, (unsigned char*)VT, P, OC, OS, OW, m, NGW, F.lane); else combine_norm_tokens<1>(ACT, (unsigned char*)VT, P, OC, OS, OW, m, NGW, F.lane); }
        }
        SEAM(pid); ++pid;
        if (IN(pid)) { REFRESH();
            pg8::Gemm g{VT, (const bf16_t*)(wl + WL_WOUT), MTOK, D_MODEL, D_MODEL / 2, D_MODEL / 2, D_MODEL / 2}; pg8::StaticOrder S; S.init(MTOK, D_MODEL, F.G, F.c);
            pg8::EpiResid E{HB, SS + (size_t)(2 * L + 1) * MTOK * 32, D_MODEL}; pg8::gemm_phase<pg8::EpiResid, pg8::StaticOrder, true, 0x7f7f7f7f, 0x79797979>(F.lds, g, S, E, F.tid);
        }
        SEAM(pid); ++pid;
        for (int ch = 0; ch < N_CHUNK; ++ch) {
            if (IN(pid)) { REFRESH();
                pg8::Gemm g{HB + (size_t)ch * MLP_CHUNK * D_MODEL, (const bf16_t*)(wl + WL_WUP), MLP_CHUNK, D_FF, D_MODEL, D_MODEL, D_MODEL}; pg8::StaticOrder S; S.init(MLP_CHUNK, D_FF, F.G, F.c);
                pg8::EpiFp8Relu2 E{(unsigned char*)HID, D_FF, SS + ((size_t)(2 * L + 1) * MTOK + (size_t)ch * MLP_CHUNK) * 32}; for (int rep7 = 0; rep7 < DUPN(7); ++rep7) { REFRESH(); pg8::gemm_phase(F.lds, g, S, E, F.tid); }
            }
            SEAM(pid); ++pid;
            if (IN(pid)) { REFRESH();
                pg8::Gemm g{HID, (const bf16_t*)(wl + WL_WDN), MLP_CHUNK, D_MODEL, D_FF / 2, D_FF / 2, D_FF / 2}; pg8::StaticOrder S; S.init(MLP_CHUNK, D_MODEL, F.G, F.c);
                pg8::EpiResid E{HB + (size_t)ch * MLP_CHUNK * D_MODEL, SS + ((size_t)(2 * L + 2) * MTOK + (size_t)ch * MLP_CHUNK) * 32, D_MODEL}; pg8::gemm_phase<pg8::EpiResid, pg8::StaticOrder, true, 0x7f7f7f7f, 0x79797979>(F.lds, g, S, E, F.tid);
            }
            SEAM(pid); ++pid;
        }
    }
    if (IN(pid)) { REFRESH();
        for (int m = gw; m < MTOK; m += NGW) rms_row_final(HB + (size_t)m * D_MODEL, F.out + (size_t)m * D_MODEL, F.in[18], SS + ((size_t)(2 * DEPTH) * MTOK + m) * 32, F.lane);
    }
    ++pid;
#undef IN
#undef SEAM
}

#ifndef MK_ONE_LAUNCH
#define MK_ONE_LAUNCH 1
#endif
extern "C" void kernel_launch(void* const* d_in, const int* in_sizes, int n_in, void* d_out, int out_size, void* d_ws, size_t ws_size, hipStream_t stream) {
    static int grid = 0;
    if (grid == 0) {
        if (n_in != 19 || out_size != MTOK * D_MODEL || ws_size < WS_END) { fprintf(stderr, "kernel_launch: unexpected shapes (n_in %d out %d ws %zu need %zu)\n", n_in, out_size, ws_size, (size_t)WS_END); grid = -1; return; }
        int dev = 0, cus = 0, per_cu = 0;
        if (hipGetDevice(&dev) != hipSuccess || hipDeviceGetAttribute(&cus, hipDeviceAttributeMultiprocessorCount, dev) != hipSuccess) { grid = -1; return; }
        if (hipFuncSetAttribute((const void*)fwd_kernel, hipFuncAttributeMaxDynamicSharedMemorySize, LDS_BYTES) != hipSuccess) { fprintf(stderr, "kernel_launch: hipFuncSetAttribute failed\n"); grid = -1; return; }
        if (hipOccupancyMaxActiveBlocksPerMultiprocessor(&per_cu, (const void*)fwd_kernel, 512, LDS_BYTES) != hipSuccess || per_cu < 1) { fprintf(stderr, "kernel_launch: occupancy query says %d\n", per_cu); }
        (void)hipGetLastError();
        grid = cus;
    }
    if (grid < 0) return;
    (void)hipMemsetAsync((char*)d_ws + WS_CTL, 0, CTL_ZERO_BYTES, stream);
    Args a{};
    for (int i = 0; i < 19; ++i) a.in[i] = (const float*)d_in[i];
    a.out = (float*)d_out; a.ws = (unsigned char*)d_ws;
#if MK_ONE_LAUNCH
    a.ph_lo = 0; a.ph_hi = NPHASE;
    hipLaunchKernelGGL(fwd_kernel, dim3(grid), dim3(512), LDS_BYTES, stream, a);
#else
    for (int p = 0; p < NPHASE; ++p) { a.ph_lo = p; a.ph_hi = p + 1; hipLaunchKernelGGL(fwd_kernel, dim3(grid), dim3(512), LDS_BYTES, stream, a); }
#endif
}
```

```cpp
#include <hip/hip_runtime.h>
#include <cstdio>
#include <cstdint>
#include <cmath>

#define LAS __attribute__((address_space(3)))
typedef unsigned short bf16_t;
typedef short bf16x8 __attribute__((ext_vector_type(8)));
typedef short s16x4 __attribute__((ext_vector_type(4)));
typedef float f32x4 __attribute__((ext_vector_type(4)));
typedef float f32x2 __attribute__((ext_vector_type(2)));
typedef float f32x16 __attribute__((ext_vector_type(16)));
typedef unsigned u32x4 __attribute__((ext_vector_type(4)));
typedef unsigned u32x2 __attribute__((ext_vector_type(2)));

constexpr int D_MODEL = 2048, BATCH = 4, SEQ = 8192, DEPTH = 2, MTOK = BATCH * SEQ;
constexpr int D_FF = 8192, IN_COLS = 4160;
constexpr float EPS = 1e-6f, NEGF = -1e30f, LOG2E = 1.4426950408889634f;
constexpr int PC_CQ = 0, PC_CKV = 384, PC_KR = 512, PC_FF = 544, PC_GATE = 552, PC_FQ = 576, PC_FK = 1088, PC_NQ = 1600, PC_KC = 2112, PC_VC = 2240,
              PC_KS = 2368, PC_VS = 2496, PC_KW = 2624, PC_SQ = 2752, PC_SK = 3264, PC_END = 3392, PN = 3584;
constexpr int VR_FV = 0, VR_WV = 512, VR_SV = 640, VR_VS = 768, VTN = 1024;
constexpr int MLP_CHUNK = 32768, N_CHUNK = MTOK / MLP_CHUNK;

#ifndef PROBE_DUP
#define PROBE_DUP 0
#endif
#define DUPN(bit) (((PROBE_DUP) >> (bit)) & 1 ? 2 : 1)
__device__ __forceinline__ unsigned f2bf(float f) { unsigned u = __builtin_bit_cast(unsigned, f); return (u + 0x7fffu + ((u >> 16) & 1u)) >> 16; }
typedef __bf16 bf16x2_t __attribute__((ext_vector_type(2)));
__device__ __forceinline__ unsigned pk2(float lo, float hi) { f32x2 v = {lo, hi}; bf16x2_t b = __builtin_convertvector(v, bf16x2_t); return __builtin_bit_cast(unsigned, b); }
__device__ __forceinline__ float bf2f(unsigned short b) { return __builtin_bit_cast(float, (unsigned)b << 16); }
__device__ __forceinline__ float bflo(unsigned w) { return __builtin_bit_cast(float, w << 16); }
__device__ __forceinline__ float bfhi(unsigned w) { return __builtin_bit_cast(float, w & 0xffff0000u); }
#define DPPF(x, CTRL) __builtin_bit_cast(float, __builtin_amdgcn_update_dpp(0, __builtin_bit_cast(int, (x)), (CTRL), 0xF, 0xF, true))
__device__ __forceinline__ float sum_x32(float v) { float a = v, b = v; asm volatile("s_nop 1\n\tv_permlane32_swap_b32 %0, %1" : "+v"(a), "+v"(b)); return a + b; }
__device__ __forceinline__ float sum_x16(float v) { float a = v, b = v; asm volatile("s_nop 1\n\tv_permlane16_swap_b32 %0, %1" : "+v"(a), "+v"(b)); return a + b; }
__device__ __forceinline__ float max_x32(float v) { float a = v, b = v; asm volatile("s_nop 1\n\tv_permlane32_swap_b32 %0, %1" : "+v"(a), "+v"(b)); return fmaxf(a, b); }
__device__ __forceinline__ float max_x16(float v) { float a = v, b = v; asm volatile("s_nop 1\n\tv_permlane16_swap_b32 %0, %1" : "+v"(a), "+v"(b)); return fmaxf(a, b); }
__device__ __forceinline__ float wave_sum(float v) {
    v += DPPF(v, 0xB1); v += DPPF(v, 0x4E); v += DPPF(v, 0x141); v += DPPF(v, 0x140);
    v = sum_x16(v); v = sum_x32(v);
    return v;
}
__device__ __forceinline__ float wave_max(float v) {
    v = fmaxf(v, DPPF(v, 0xB1)); v = fmaxf(v, DPPF(v, 0x4E)); v = fmaxf(v, DPPF(v, 0x141)); v = fmaxf(v, DPPF(v, 0x140));
    v = max_x16(v); v = max_x32(v);
    return v;
}
__device__ __forceinline__ float fexp2(float x) { return __builtin_amdgcn_exp2f(x); }
template <int CTRL> __device__ __forceinline__ float dpp_f(float x) { return __builtin_bit_cast(float, __builtin_amdgcn_update_dpp(0, __builtin_bit_cast(int, x), CTRL, 0xF, 0xF, true)); }
template <int CTRL> __device__ __forceinline__ int dpp_i(int x) { return __builtin_amdgcn_update_dpp(0, x, CTRL, 0xF, 0xF, true); }
#define LDS_FENCE() asm volatile("s_waitcnt lgkmcnt(0)" ::: "memory")

__device__ __forceinline__ int lane_now() { int l; asm volatile("v_mbcnt_lo_u32_b32 %0, -1, 0\n\tv_mbcnt_hi_u32_b32 %0, -1, %0" : "=v"(l)); return l; }
#define XB_TMO      128
#define XB_XCNT(j)  (256  + 64 * (j))
#define XB_XSUB(j)  (1280 + 64 * (j))
#define XB_XGEN(j)  (2304 + 64 * (j))
#define XB_TOP      3328
#define XB_TOPGEN   3392
#define XCD_BAR_WORDS 3456
#define XB_SPIN_CAP (1u << 18)
__device__ __forceinline__ unsigned xb_ld(unsigned* p)              { return __hip_atomic_load(p, __ATOMIC_RELAXED, __HIP_MEMORY_SCOPE_AGENT); }
__device__ __forceinline__ unsigned xb_add(unsigned* p, unsigned v) { return __hip_atomic_fetch_add(p, v, __ATOMIC_RELAXED, __HIP_MEMORY_SCOPE_AGENT); }
__device__ __forceinline__ unsigned xb_xcc_id() { return (unsigned)__builtin_amdgcn_s_getreg((3 << 11) | 20) & 0xFu; }
#define XB_SPIN(cond, bar) do { unsigned _sp = 0; while (cond) { __builtin_amdgcn_s_sleep(1); \
    if ((++_sp & 255u) == 0u) { if (xb_ld(&(bar)[XB_TMO])) break; if (_sp > XB_SPIN_CAP) { atomicAdd(&(bar)[XB_TMO], 1u); break; } } } } while (0)
struct XcdBarrier { unsigned* bar; unsigned x; volatile LAS unsigned* st; int w0; };
__device__ __forceinline__ XcdBarrier xcd_barrier_post(unsigned* bar, volatile LAS unsigned* st) {
    XcdBarrier b; b.bar = bar; b.x = xb_xcc_id(); b.st = st; b.w0 = __builtin_amdgcn_readfirstlane(threadIdx.x >> 6) == 0;
    if (threadIdx.x == 0) (void)xb_add(&bar[XB_XCNT(b.x)], 1u);
    return b;
}
__device__ __forceinline__ void xcd_barrier_complete(unsigned* bar, unsigned x, unsigned& nloc, unsigned& nx) {
    const unsigned G = gridDim.x * gridDim.y * gridDim.z;
    unsigned sum, cnt, mine, sp = 0u;
    for (;;) {
        sum = 0u; cnt = 0u; mine = 0u;
#pragma unroll
        for (unsigned j = 0; j < 16; ++j) { const unsigned c = xb_ld(&bar[XB_XCNT(j)]); sum += c; cnt += (c > 0u) ? 1u : 0u; mine = (j == x) ? c : mine; }
        if (sum == G) break;
        __builtin_amdgcn_s_sleep(1);
        if ((++sp & 255u) == 0u) { if (xb_ld(&bar[XB_TMO])) break; if (sp > XB_SPIN_CAP) { atomicAdd(&bar[XB_TMO], 1u); break; } }
    }
    nloc = mine > 0u ? mine : 1u; nx = cnt > 0u ? cnt : 1u;
}
__device__ __forceinline__ void xcd_barrier(const XcdBarrier& b) {
    asm volatile("s_waitcnt vmcnt(0)" ::: "memory");
    __syncthreads();
    if (b.w0 && lane_now() == 0) {
        unsigned* bar = b.bar;
        __builtin_amdgcn_s_waitcnt(0);
        unsigned nloc = b.st[0], nx = b.st[1];
        if (nloc == 0u) { xcd_barrier_complete(bar, b.x, nloc, nx); b.st[0] = nloc; b.st[1] = nx; }
        const unsigned old = xb_add(&bar[XB_XSUB(b.x)], 1u);
        const unsigned gen = old / nloc;
        if (old + 1u == (gen + 1u) * nloc) {
            __builtin_amdgcn_fence(__ATOMIC_RELEASE, "agent");
            asm volatile("s_waitcnt vmcnt(0)" ::: "memory");
            const unsigned og = xb_add(&bar[XB_TOP], 1u);
            const unsigned tg = og / nx;
            if (og + 1u == (tg + 1u) * nx) xb_add(&bar[XB_TOPGEN], 1u);
            else XB_SPIN(xb_ld(&bar[XB_TOPGEN]) == tg, bar);
            __builtin_amdgcn_fence(__ATOMIC_ACQUIRE, "agent");
            xb_add(&bar[XB_XGEN(b.x)], 1u);
            asm volatile("s_waitcnt vmcnt(0)" ::: "memory");
        } else {
            XB_SPIN(xb_ld(&bar[XB_XGEN(b.x)]) == gen, bar);
            __builtin_amdgcn_fence(__ATOMIC_ACQUIRE, "agent");
            asm volatile("s_waitcnt vmcnt(0)" ::: "memory");
        }
    }
    __syncthreads();
}

namespace pg8 {
constexpr int BM = 256, BK = 64, HALF = 128, HTB = HALF * BK * 2, STAGE_BYTES = 8 * HTB, NXCD = 8, WGM = 8;
__host__ __device__ __forceinline__ int lds_byte(int r, int c) { const int st = (r >> 4) * 2 + (c >> 5), rr = r & 15, cc = c & 31, ob = rr * 64 + cc * 2; return st * 1024 + (ob ^ (((ob >> 9) & 1) << 5)); }
__host__ __device__ __forceinline__ void stage_rc(int b, int& R, int& C) { const int st = b / 1024, sb = b % 1024, swz = sb ^ (((sb >> 9) & 1) << 5); R = (st >> 1) * 16 + swz / 64; C = (st & 1) * 32 + (swz % 64) / 2; }
__host__ __device__ __forceinline__ int perm32(int rho) { const int n = rho >> 4, i = rho & 15; return 8 * (i >> 2) + 4 * n + (i & 3); }
struct Unit { int pm, pn; };
struct Gemm { const bf16_t* A; const bf16_t* Bt; int M, N, K, lda, ldb; };
struct StaticOrder {
    int nM, nN, nwg, G, c;
    __host__ __device__ void init(int M, int N, int G_, int c_) { nM = M / BM; nN = N / BM; nwg = nM * nN; G = G_; c = c_; }
    __host__ __device__ bool next(int i, Unit& u) const {
        const long L = (long)i * G + c; if (L >= nwg) return false;
        int wgid = (int)L; { const int q = nwg / NXCD, r = nwg % NXCD, xcd = wgid % NXCD, off = wgid / NXCD; wgid = (xcd < r ? xcd * (q + 1) : r * (q + 1) + (xcd - r) * q) + off; }
        const int nig = WGM * nN, gid = wgid / nig, fm = gid * WGM, gsz = (nM - fm) < WGM ? (nM - fm) : WGM;
        u.pm = fm + ((wgid % nig) % gsz); u.pn = (wgid % nig) / gsz; return true;
    }
};
__device__ __forceinline__ unsigned cvt_pk_bf16(float lo, float hi) { unsigned r; asm volatile("v_cvt_pk_bf16_f32 %0, %1, %2" : "=v"(r) : "v"(lo), "v"(hi)); return r; }

template <int NV>
__device__ __forceinline__ float rs_ofn(const float* ssrow, float invd) {
    const f32x4* p = (const f32x4*)ssrow; float s = 0.f;
#pragma unroll
    for (int i = 0; i < NV; ++i) { const f32x4 v = p[i]; s += (v[0] + v[1]) + (v[2] + v[3]); }
    return 1.0f / sqrtf(s * invd + 1e-6f);
}
__device__ __forceinline__ float rs_of(const float* ssrow) { return rs_ofn<8>(ssrow, 1.0f / 2048.0f); }
#ifndef EARLY_A
#define EARLY_A true
#endif
#ifndef EARLY_B
#define EARLY_B true
#endif
constexpr int RST_OFF = 131072;
template <int NV>
__device__ __forceinline__ void rst_issue(f32x4 (&v)[4], const float* ss, int tok0, int tid) {
    const int tok = tok0 + (tid >> 1), half = tid & 1;
#pragma unroll
    for (int i = 0; i < 4; ++i) v[i] = (f32x4){0.f, 0.f, 0.f, 0.f};
    if constexpr (NV == 8) { const f32x4* p = (const f32x4*)(ss + (size_t)tok * 32 + half * 16);
#pragma unroll
        for (int i = 0; i < 4; ++i) v[i] = p[i]; }
    else if constexpr (NV == 2) { v[0] = *(const f32x4*)(ss + (size_t)tok * 8 + half * 4); }
    else { if (half == 0) v[0] = *(const f32x4*)(ss + (size_t)tok * 4); }
}
__device__ __forceinline__ void rst_finish(const f32x4 (&v)[4], float invd, LAS float* tbl, int tid) {
    float s = ((v[0][0] + v[0][1]) + (v[0][2] + v[0][3])) + ((v[1][0] + v[1][1]) + (v[1][2] + v[1][3]));
    s += ((v[2][0] + v[2][1]) + (v[2][2] + v[2][3])) + ((v[3][0] + v[3][1]) + (v[3][2] + v[3][3]));
    s += DPPF(s, 0xB1);
    if ((tid & 1) == 0) tbl[tid >> 1] = 1.0f / sqrtf(s * invd + 1e-6f);
}
template <int ACT  , int SCALE, int NV = 8, bool MSTAT = false> struct EpiBf16 {
    static constexpr bool PERM = true; static constexpr int RSNV = SCALE ? NV : 0; static constexpr bool RSCOL = SCALE == 2; static constexpr bool RSEARLY = EARLY_A;
    bf16_t* O; int ldc; const float* ss; float invd; float* mq; float* mkv;
    __device__ __forceinline__ float rsinvd() const { return invd; }
    __device__ __forceinline__ void operator()(const f32x4 (&acc)[2][2][4][2], const Unit& u, int wr, int wc, int fr, int fq, const LAS float* rst) const {
        const int row0 = u.pm * BM + wr * 64 + fr, col0 = u.pn * BM + wc * 64 + 16 * fq;
#pragma unroll
        for (int ai = 0; ai < 2; ++ai)
#pragma unroll
            for (int m = 0; m < 4; ++m) { const int row = row0 + ai * HALF + m * 16; bf16_t* rowp = O + (size_t)row * ldc + col0; float msq = 0.f;
#pragma unroll
                for (int bj = 0; bj < 2; ++bj) { f32x4 v0 = acc[ai][bj][m][0], v1 = acc[ai][bj][m][1];
                    if (SCALE == 1) { const float rsr = rst[wr * 64 + fr + ai * HALF + m * 16]; v0 = v0 * rsr; v1 = v1 * rsr; }
                    if (SCALE == 2) { const LAS f32x4* cs = (const LAS f32x4*)(rst + wc * 64 + 16 * fq + 8 * bj); v0 = v0 * cs[0]; v1 = v1 * cs[1]; }
                    if (ACT == 2) {
#pragma unroll
                        for (int e = 0; e < 4; ++e) { const float a = fmaxf(v0[e], 0.f), b = fmaxf(v1[e], 0.f); v0[e] = a * a; v1[e] = b * b; } }
                    u32x4 w; w.x = cvt_pk_bf16(v0[0], v0[1]); w.y = cvt_pk_bf16(v0[2], v0[3]); w.z = cvt_pk_bf16(v1[0], v1[1]); w.w = cvt_pk_bf16(v1[2], v1[3]);
                    *(u32x4*)(rowp + bj * 8) = w;
                    if (MSTAT && u.pn < 2) msq += ((v0[0] * v0[0] + v0[1] * v0[1]) + (v0[2] * v0[2] + v0[3] * v0[3])) + ((v1[0] * v1[0] + v1[1] * v1[1]) + (v1[2] * v1[2] + v1[3] * v1[3])); }
                if (MSTAT) { if (u.pn < 2) { msq = sum_x16(msq); msq = sum_x32(msq);
                    if (fq == 0) { if (u.pn == 0) mq[(size_t)row * 8 + wc] = msq;
                        else if (wc < 2) { mq[(size_t)row * 8 + 4 + wc] = msq; mkv[(size_t)row * 4 + 2 + wc] = 0.f; }
                        else { mkv[(size_t)row * 4 + wc - 2] = msq; mq[(size_t)row * 8 + 4 + wc] = 0.f; } } } } }
    }
};
struct EpiFp8Relu2 {
    static constexpr bool PERM = true; static constexpr int RSNV = 8; static constexpr bool RSCOL = false; static constexpr bool RSEARLY = EARLY_B;
    unsigned char* O; int ldc; const float* ss;
    __device__ __forceinline__ float rsinvd() const { return 1.0f / 2048.0f; }
    __device__ __forceinline__ void operator()(const f32x4 (&acc)[2][2][4][2], const Unit& u, int wr, int wc, int fr, int fq, const LAS float* rst) const {
        const int row0 = u.pm * BM + wr * 64 + fr, col0 = u.pn * BM + wc * 64 + 16 * fq;

#pragma unroll
        for (int ai = 0; ai < 2; ++ai)
#pragma unroll
            for (int m = 0; m < 4; ++m) { const int row = row0 + ai * HALF + m * 16; unsigned char* rowp = O + (size_t)row * ldc + col0;
                const float rsr = rst[wr * 64 + fr + ai * HALF + m * 16]; u32x4 wout;
#pragma unroll
                for (int bj = 0; bj < 2; ++bj) { f32x4 v0 = acc[ai][bj][m][0] * rsr, v1 = acc[ai][bj][m][1] * rsr;
#pragma unroll
                    for (int e = 0; e < 4; ++e) { const float a = fmaxf(v0[e], 0.f), b = fmaxf(v1[e], 0.f); v0[e] = fminf(a * a, 448.f); v1[e] = fminf(b * b, 448.f); }
                    int w0 = 0, w1 = 0;
                    w0 = __builtin_amdgcn_cvt_pk_fp8_f32(v0[0], v0[1], w0, false); w0 = __builtin_amdgcn_cvt_pk_fp8_f32(v0[2], v0[3], w0, true);
                    w1 = __builtin_amdgcn_cvt_pk_fp8_f32(v1[0], v1[1], w1, false); w1 = __builtin_amdgcn_cvt_pk_fp8_f32(v1[2], v1[3], w1, true);
                    wout[2 * bj] = (unsigned)w0; wout[2 * bj + 1] = (unsigned)w1; }
                *(u32x4*)rowp = wout; }
    }
};
struct EpiResid {
    static constexpr bool PERM = true; static constexpr int RSNV = 0; static constexpr bool RSCOL = false; static constexpr bool RSEARLY = false;
    bf16_t* hb; float* ss; int ldc;
    __device__ __forceinline__ void operator()(const f32x4 (&acc)[2][2][4][2], const Unit& u, int wr, int wc, int fr, int fq) const {
        const int col0 = u.pn * BM + wc * 64 + 16 * fq;
#pragma unroll
        for (int ai = 0; ai < 2; ++ai) {
            u32x4 res[1][4][2];
#pragma unroll
            for (int m = 0; m < 4; ++m) { const bf16_t* rowp = hb + (size_t)(u.pm * BM + ai * HALF + wr * 64 + m * 16 + fr) * ldc + col0;
#pragma unroll
                for (int bj = 0; bj < 2; ++bj) res[0][m][bj] = *(const u32x4*)(rowp + bj * 8); }
#pragma unroll
            for (int m = 0; m < 4; ++m) { const int row = u.pm * BM + ai * HALF + wr * 64 + m * 16 + fr; bf16_t* rowp = hb + (size_t)row * ldc + col0;
                float sq = 0.f;
#pragma unroll
                for (int bj = 0; bj < 2; ++bj) { const u32x4 b = res[0][m][bj];
                    const f32x4 h0 = acc[ai][bj][m][0] + (f32x4){bflo(b.x), bfhi(b.x), bflo(b.y), bfhi(b.y)}, h1 = acc[ai][bj][m][1] + (f32x4){bflo(b.z), bfhi(b.z), bflo(b.w), bfhi(b.w)};
                    u32x4 w; w.x = cvt_pk_bf16(h0[0], h0[1]); w.y = cvt_pk_bf16(h0[2], h0[3]); w.z = cvt_pk_bf16(h1[0], h1[1]); w.w = cvt_pk_bf16(h1[2], h1[3]);
                    *(u32x4*)(rowp + bj * 8) = w;
                    sq += ((h0[0] * h0[0] + h0[1] * h0[1]) + (h0[2] * h0[2] + h0[3] * h0[3])) + ((h1[0] * h1[0] + h1[1] * h1[1]) + (h1[2] * h1[2] + h1[3] * h1[3])); }
                sq = sum_x16(sq); sq = sum_x32(sq);
                if (fq == 0) ss[(size_t)row * 32 + u.pn * 4 + wc] = sq; } }
    }
};

typedef int i32x8 __attribute__((ext_vector_type(8)));
template <class Epi, class Sched, bool FP8 = false, int SA = 0x7f7f7f7f, int SB = 0x7f7f7f7f>
__device__ __forceinline__ void gemm_phase(LAS unsigned char* lds, const Gemm g, const Sched& S, const Epi& E, int tid_) {
    const int tid = tid_, wid = __builtin_amdgcn_readfirstlane(tid >> 6), lane = tid & 63, wr = wid >> 2, wc = wid & 3, fr = lane & 15, fq = lane >> 4;
    const int K = g.K, nt = K / BK;
    unsigned voffA[2], voffB[2];
#pragma unroll
    for (int i = 0; i < 2; ++i) { int R, C; stage_rc(tid * 16 + i * 8192, R, C); const int Rb = Epi::PERM ? (64 * (R >> 5) + 16 * ((R >> 2) & 3) + 4 * ((R >> 4) & 1) + (R & 3)) : R;
        voffA[i] = (unsigned)(R * g.lda + C) * 2u; voffB[i] = (unsigned)(Rb * g.ldb + C) * 2u; }
    const size_t kstep = (size_t)(BK * 2);
    const size_t hstepA = (size_t)HALF * g.lda * 2, hstepB = (size_t)(Epi::PERM ? 8 : HALF) * g.ldb * 2;
    const size_t tstepA = 2 * hstepA, tstepB = (size_t)BM * g.ldb * 2;
    const unsigned ldsw = (unsigned)wid * 1024u;
    const int aoff = lds_byte(wr * 64 + fr, FP8 ? fq * 16 : fq * 8), boff = lds_byte(wc * 32 + fr, FP8 ? fq * 16 : fq * 8);
#define PG8_SA(b, h) (((b) * 2 + (h)) * HTB)
#define PG8_SB(b, h) ((4 + (b) * 2 + (h)) * HTB)
#define PG8_STAGE(bufoff, gbase, voff) do { _Pragma("unroll") for (int _i = 0; _i < 2; ++_i) \
        __builtin_amdgcn_global_load_lds((const unsigned*)((const char*)(gbase) + (voff)[_i]), (LAS unsigned*)(lds + (bufoff) + ldsw + _i * 8192), 16, 0, 0); } while (0)
#define PG8_LD32(p) __builtin_bit_cast(i32x8, __builtin_shufflevector(*(const LAS bf16x8*)(p), *(const LAS bf16x8*)((p) + 16), 0, 1, 2, 3, 4, 5, 6, 7, 8, 9, 10, 11, 12, 13, 14, 15))
#define PG8_LDA(dst, b, h) do { _Pragma("unroll") for (int m = 0; m < 4; ++m) { if constexpr (FP8) dst##8[m] = PG8_LD32(lds + PG8_SA(b, h) + aoff + m * 2048); \
        else { _Pragma("unroll") for (int k = 0; k < 2; ++k) dst[m][k] = *(const LAS bf16x8*)(lds + PG8_SA(b, h) + aoff + m * 2048 + k * 1024); } } } while (0)
#define PG8_LDB(dst, b, h) do { _Pragma("unroll") for (int n = 0; n < 2; ++n) { if constexpr (FP8) dst##8[n] = PG8_LD32(lds + PG8_SB(b, h) + boff + n * 2048); \
        else { _Pragma("unroll") for (int k = 0; k < 2; ++k) dst[n][k] = *(const LAS bf16x8*)(lds + PG8_SB(b, h) + boff + n * 2048 + k * 1024); } } } while (0)
#define PG8_MMA(ai, bj, At, Bt) do { __builtin_amdgcn_s_setprio(1); _Pragma("unroll") for (int m = 0; m < 4; ++m) _Pragma("unroll") for (int n = 0; n < 2; ++n) { \
        if constexpr (FP8) asm volatile("v_mfma_scale_f32_16x16x128_f8f6f4 %0, %1, %2, %0, %3, %4 op_sel_hi:[0,0,0]" : "+v"(acc[ai][bj][m][n]) : "v"(Bt##8[n]), "v"(At##8[m]), "v"(vsb), "v"(vsa));     \
        else { _Pragma("unroll") for (int k = 0; k < 2; ++k) acc[ai][bj][m][n] = __builtin_amdgcn_mfma_f32_16x16x32_bf16(Bt[n][k], At[m][k], acc[ai][bj][m][n], 0, 0, 0); } } \
        __builtin_amdgcn_s_setprio(0); } while (0)
#define PG8_WAIT_V(n) asm volatile("s_waitcnt vmcnt(" #n ")" ::: "memory")
#define PG8_WAIT_L(n) asm volatile("s_waitcnt lgkmcnt(" #n ")" ::: "memory")
#define PG8_BAR __builtin_amdgcn_s_barrier()
#define PG8_SCHED __builtin_amdgcn_sched_barrier(0)
    Unit cur, nxt; int ui = 0;
    if (!S.next(0, cur)) return;
    f32x4 rsl[4]; LAS float* rstab = (LAS float*)(lds + RST_OFF); int rsb = 0;
    if constexpr (Epi::RSNV > 0) rst_issue<Epi::RSNV>(rsl, E.ss, (Epi::RSCOL ? cur.pn : cur.pm) * BM, tid);
    f32x4 acc[2][2][4][2];
#pragma unroll
    for (int a = 0; a < 2; ++a)
#pragma unroll
        for (int b = 0; b < 2; ++b)
#pragma unroll
            for (int m = 0; m < 4; ++m)
#pragma unroll
                for (int n = 0; n < 2; ++n) acc[a][b][m][n] = (f32x4){0.f, 0.f, 0.f, 0.f};
    const int vsa = SA, vsb = SB;
    bf16x8 At[4][2], B0[2][2], B1[2][2]; i32x8 At8[4], B08[2], B18[2];
    const char* cA = (const char*)g.A + (size_t)cur.pm * tstepA; const char* cB = (const char*)g.Bt + (size_t)cur.pn * tstepB;
    PG8_STAGE(PG8_SB(0, 0), cB, voffB); PG8_STAGE(PG8_SB(0, 1), cB + hstepB, voffB); PG8_STAGE(PG8_SA(0, 0), cA, voffA); PG8_STAGE(PG8_SA(0, 1), cA + hstepA, voffA);
    if constexpr (Epi::RSNV > 0) rst_finish(rsl, E.rsinvd(), rstab, tid);
    if (wr == 1) PG8_BAR;
    PG8_WAIT_V(2); PG8_BAR;
    PG8_STAGE(PG8_SB(1, 0), cB + kstep, voffB); PG8_STAGE(PG8_SA(1, 0), cA + kstep, voffA); PG8_STAGE(PG8_SB(1, 1), cB + hstepB + kstep, voffB);
    PG8_WAIT_V(6); PG8_BAR;
    for (;;) {
        const bool has_next = S.next(ui + 1, nxt);
        const char* nA = has_next ? (const char*)g.A + (size_t)nxt.pm * tstepA : cA; const char* nB = has_next ? (const char*)g.Bt + (size_t)nxt.pn * tstepB : cB;
#pragma unroll 1
        for (int t = 0; t < nt; t += 2) {
            const bool last = (t == nt - 2);
            const char* a1 = cA + (size_t)(t + 1) * kstep;
            const char* a2 = last ? nA : cA + (size_t)(t + 2) * kstep; const char* b2 = last ? nB : cB + (size_t)(t + 2) * kstep;
            const char* a3 = a2 + kstep; const char* b3 = b2 + kstep;
            PG8_LDB(B0, 0, 0); PG8_LDB(B1, 0, 1); PG8_SCHED; PG8_LDA(At, 0, 0); PG8_STAGE(PG8_SA(1, 1), a1 + hstepA, voffA);
            PG8_WAIT_V(8); PG8_WAIT_L(0); PG8_BAR; PG8_MMA(0, 0, At, B0); PG8_MMA(0, 1, At, B1); PG8_BAR; PG8_SCHED;
            PG8_LDA(At, 0, 1); PG8_STAGE(PG8_SB(0, 0), b2, voffB); PG8_STAGE(PG8_SB(0, 1), b2 + hstepB, voffB); PG8_STAGE(PG8_SA(0, 0), a2, voffA);
            PG8_WAIT_V(8); PG8_WAIT_L(0); PG8_BAR; PG8_MMA(1, 0, At, B0); PG8_MMA(1, 1, At, B1); PG8_BAR; PG8_SCHED;
            PG8_LDB(B0, 1, 0); PG8_LDB(B1, 1, 1); PG8_SCHED; PG8_LDA(At, 1, 0); PG8_STAGE(PG8_SA(0, 1), a2 + hstepA, voffA);
            PG8_WAIT_V(8); PG8_WAIT_L(0); PG8_BAR; PG8_MMA(0, 0, At, B0); PG8_MMA(0, 1, At, B1); PG8_BAR; PG8_SCHED;
            PG8_LDA(At, 1, 1); PG8_STAGE(PG8_SB(1, 0), b3, voffB); PG8_STAGE(PG8_SB(1, 1), b3 + hstepB, voffB); PG8_STAGE(PG8_SA(1, 0), a3, voffA);
            PG8_WAIT_V(8); PG8_WAIT_L(0); PG8_BAR; PG8_MMA(1, 0, At, B0); PG8_MMA(1, 1, At, B1); PG8_BAR; PG8_SCHED;
        }
        if (wr == 0) PG8_BAR;
        if constexpr (FP8) asm volatile("s_nop 15\n\ts_nop 15" ::: "memory");
        if constexpr (Epi::RSNV > 0) {
            const bool newpanel = has_next && (Epi::RSCOL ? nxt.pn != cur.pn : nxt.pm != cur.pm);
            if constexpr (Epi::RSEARLY) { if (newpanel) rst_issue<Epi::RSNV>(rsl, E.ss, (Epi::RSCOL ? nxt.pn : nxt.pm) * BM, tid); }
            E(acc, cur, wr, wc, fr, fq, rstab + rsb * 256);
            if constexpr (!Epi::RSEARLY) { if (newpanel) rst_issue<Epi::RSNV>(rsl, E.ss, (Epi::RSCOL ? nxt.pn : nxt.pm) * BM, tid); }
            if (newpanel) { rsb ^= 1; rst_finish(rsl, E.rsinvd(), rstab + rsb * 256, tid); }
        } else E(acc, cur, wr, wc, fr, fq);
        if (!has_next) break;
#pragma unroll
        for (int a = 0; a < 2; ++a)
#pragma unroll
            for (int b = 0; b < 2; ++b)
#pragma unroll
                for (int m = 0; m < 4; ++m)
#pragma unroll
                    for (int n = 0; n < 2; ++n) acc[a][b][m][n] = (f32x4){0.f, 0.f, 0.f, 0.f};
        cur = nxt; cA = nA; cB = nB; ++ui;
        if (wr == 1) PG8_BAR;
    }
    PG8_WAIT_V(0);
    PG8_BAR;
#undef PG8_SA
#undef PG8_SB
#undef PG8_STAGE
#undef PG8_LDA
#undef PG8_LDB
#undef PG8_MMA
#undef PG8_LD32
#undef PG8_WAIT_V
#undef PG8_WAIT_L
#undef PG8_BAR
#undef PG8_SCHED
}
}

constexpr size_t MiB = 1u << 20;
constexpr size_t WS_CTL = 0, CTL_ZERO_BYTES = 64 * 1024;
constexpr size_t SZ_WIN = (size_t)PN * D_MODEL * 2, SZ_WINV = (size_t)VTN * D_MODEL * 2, SZ_WUQ = (size_t)768 * 384 * 2, SZ_WUKVK = (size_t)512 * 256 * 2, SZ_WUKVV = (size_t)512 * 256 * 2,
                 SZ_WOUT = (size_t)D_MODEL * D_MODEL * 2, SZ_WUP = (size_t)D_FF * D_MODEL * 2, SZ_WDN = (size_t)D_MODEL * D_FF * 2, SZ_W1T = (size_t)2 * 64 * 2048 * 2, SZ_CB1 = 2 * 64 * 4;
constexpr size_t WL_WIN = 0, WL_WINV = WL_WIN + SZ_WIN, WL_WUQ = WL_WINV + SZ_WINV, WL_WUKVK = WL_WUQ + SZ_WUQ, WL_WUKVV = WL_WUKVK + SZ_WUKVK, WL_WOUT = WL_WUKVV + SZ_WUKVV,
                 WL_WUP = WL_WOUT + SZ_WOUT, WL_WDN = WL_WUP + SZ_WUP, WL_W1T = WL_WDN + SZ_WDN, WL_CB1 = WL_W1T + SZ_W1T, WL_SIZE = ((WL_CB1 + SZ_CB1 + 4095) / 4096) * 4096;
constexpr size_t WS_W = 1 * MiB;
constexpr size_t WS_ACT = WS_W + DEPTH * WL_SIZE;
constexpr size_t WS_P = WS_ACT + (size_t)MTOK * D_MODEL * 2;
constexpr size_t WS_VT = WS_P + (size_t)MTOK * PN * 2;
constexpr size_t WS_MQ = WS_VT + (size_t)1024 * MTOK * 2;
constexpr size_t WS_MK = WS_MQ + (size_t)MTOK * 768 * 2;
constexpr size_t WS_MVT = WS_MK + (size_t)MTOK * 512 * 2;
constexpr size_t WS_OC = WS_MVT + (size_t)512 * MTOK * 2;
constexpr size_t WS_OS = WS_OC + (size_t)MTOK * 512 * 2, WS_OW = WS_OS + (size_t)MTOK * 512 * 2;
constexpr size_t WS_FC = WS_OW + (size_t)MTOK * 512 * 2;
constexpr size_t WS_KCMP = WS_FC + (size_t)BATCH * 8 * SEQ * 4;
constexpr size_t WS_VCMPT = WS_KCMP + (size_t)BATCH * 2 * 512 * 64 * 2;
constexpr size_t WS_KT = WS_VCMPT + (size_t)BATCH * 2 * 64 * 512 * 2 + 65536;
constexpr size_t WS_HB = WS_KT + 2 * (size_t)BATCH * 8 * 128 * 4 + 32768;
constexpr size_t WS_SS = WS_HB + (size_t)MTOK * D_MODEL * 2;
constexpr size_t WS_KR = WS_SS + 5 * (size_t)MTOK * 32 * 4;
constexpr size_t WS_MSQ = WS_KR + (size_t)MTOK * 32 * 2, WS_MSKV = WS_MSQ + (size_t)MTOK * 8 * 4;
constexpr size_t WS_END = WS_MSKV + (size_t)MTOK * 4 * 4;
static_assert((size_t)MLP_CHUNK * D_FF <= (size_t)MTOK * PN * 2 + (size_t)1024 * MTOK * 2, "hidden (fp8) overlays P and VT (both dead during the MLP)");

constexpr int RING_BYTES = 131072, LDS_BYTES = 163840, LDSCTL_OFF = LDS_BYTES - 1024;
static_assert(pg8::RST_OFF == RING_BYTES && pg8::RST_OFF + 2048 <= LDSCTL_OFF, "token-scale tables sit right behind the GEMM ring");
constexpr int A_K = 0, A_KSTR64 = 144, A_KSTR96 = 208, A_V = 13312, A_VSTR = 136, A_FK = A_V + 64 * A_VSTR;
constexpr int N_KS = 64 * A_KSTR64, N_VS = 64 * A_VSTR, N_K0 = 0, N_V0 = 2 * N_KS, A_IMP = N_V0 + 2 * N_VS, A_END = A_IMP + 65536;
constexpr int SW_BYTES = 64 * A_KSTR64 + 64 * A_VSTR;
constexpr int A_TBSTR = 132, A_TB = 8 * SW_BYTES, A_SEL = A_TB + 8 * A_TBSTR * 4, A_WM = A_SEL + 1024, A_TOP = A_WM + 128;
static_assert(A_END <= RING_BYTES && A_TOP <= LDSCTL_OFF && A_TB >= RING_BYTES, "attention LDS map");

struct Frame {
    LAS unsigned char* lds;
    int tid, lane, wave, G, c;
    const float* in[19]; float* out; unsigned char* ws;
};

struct ColMap { int src; float cs; };
constexpr float QSC = 0.125f * LOG2E;
constexpr float MLA_QSC = 0.10206207261596575f * LOG2E;
__device__ __forceinline__ ColMap map_win_rm(int n) {
    ColMap r; r.cs = 1.f;
    if (n < 544) r.src = n;
    else if (n < 552) r.src = 2080 + (n - 544);
    else if (n < 576) r.src = 3368 + (n - 552);
    else if (n < 1088) { r.src = 544 + (n - 576); r.cs = QSC; }
    else if (n < 1600) r.src = 1056 + (n - 1088);
    else if (n < 2112) { r.src = 2088 + (n - 1600); r.cs = QSC; }
    else if (n < 2240) r.src = 2600 + (n - 2112);
    else if (n < 2368) r.src = 2728 + (n - 2240);
    else if (n < 2496) r.src = 2856 + (n - 2368);
    else if (n < 2624) r.src = 2984 + (n - 2496);
    else if (n < 2752) r.src = 3112 + (n - 2624);
    else if (n < 3264) { r.src = 3392 + (n - 2752); r.cs = QSC; }
    else if (n < 3392) r.src = 3904 + (n - 3264);
    else r.src = -1;
    return r;
}
__device__ __forceinline__ ColMap map_win_v(int n) {
    ColMap r; r.cs = 1.f;
    if (n < 512) r.src = 1568 + n;
    else if (n < 640) r.src = 3240 + (n - 512);
    else if (n < 768) r.src = 4032 + (n - 640);
    else if (n < 896) r.src = 2984 + (n - 768);
    else r.src = -1;
    return r;
}
__device__ __forceinline__ ColMap map_id(int n) { ColMap r; r.src = n; r.cs = 1.f; return r; }
__device__ __forceinline__ ColMap map_uq(int n) { ColMap r; r.src = n; r.cs = MLA_QSC; return r; }
__device__ __forceinline__ ColMap map_ukv_k(int n) { ColMap r; r.src = (n >> 6) * 128 + (n & 63); r.cs = 1.f; return r; }
__device__ __forceinline__ ColMap map_ukv_v(int n) { ColMap r; r.src = (n >> 6) * 128 + 64 + (n & 63); r.cs = 1.f; return r; }

template <class MapF>
__device__ __forceinline__ void titem_load(f32x4 (&tv)[8], float (&tsc)[8], unsigned char*& tdst, int& tK, bool& tfp8, const float* W, int Krows, int Nsrc, void* WT, int K, const float* rowgain, MapF mapf, int item, int nblk, int lane, bool fp8) {
    const int kb = item / nblk, nb = item % nblk, k0 = 64 * kb, n0 = 32 * nb;
    const int kr = lane >> 3, nc = 4 * (lane & 7);
    const ColMap cm = mapf(n0 + nc);
#pragma unroll
    for (int i = 0; i < 8; ++i) { const int k = k0 + 8 * i + kr; const bool ok = cm.src >= 0 && k < Krows;
        tv[i] = (f32x4){0.f, 0.f, 0.f, 0.f}; tsc[i] = fp8 ? 64.0f * cm.cs : cm.cs;
        if (ok) { tv[i] = *(const f32x4*)(W + (size_t)k * Nsrc + cm.src); if (rowgain) tsc[i] *= rowgain[k]; } }
    tdst = (unsigned char*)WT + ((size_t)n0 * K + k0) * (fp8 ? 1 : 2); tK = K; tfp8 = fp8;
}
__device__ __forceinline__ void titem_finish(const f32x4 (&tv)[8], const float (&tsc)[8], unsigned char* tdst, int tK, bool tfp8, LAS float* scr, int lane) {
    const int kr = lane >> 3, nc = 4 * (lane & 7);
#pragma unroll
    for (int i = 0; i < 8; ++i) *(LAS f32x4*)(scr + (8 * i + kr) * 36 + nc) = tv[i] * tsc[i];
    LDS_FENCE();
    if (tfp8) {
        const int n = lane >> 1, kh = 32 * (lane & 1);
        const LAS float* s = scr + kh * 36 + n;
        u32x4 o[2];
#pragma unroll
        for (int q = 0; q < 2; ++q)
#pragma unroll
            for (int d = 0; d < 4; ++d) { const LAS float* p = s + (16 * q + 4 * d) * 36; int w = 0;
                w = __builtin_amdgcn_cvt_pk_fp8_f32(p[0], p[36], w, false); w = __builtin_amdgcn_cvt_pk_fp8_f32(p[72], p[108], w, true); o[q][d] = (unsigned)w; }
        unsigned char* dp = tdst + (size_t)n * tK + kh;
        *(u32x4*)dp = o[0]; *(u32x4*)(dp + 16) = o[1];
    } else {
        const int c = lane & 7;
#pragma unroll
        for (int j = 0; j < 4; ++j) { const int n = (lane >> 3) + 8 * j; const LAS float* s = scr + (8 * c) * 36 + n;
            u32x4 o; o.x = pk2(s[0 * 36], s[1 * 36]); o.y = pk2(s[2 * 36], s[3 * 36]); o.z = pk2(s[4 * 36], s[5 * 36]); o.w = pk2(s[6 * 36], s[7 * 36]);
            *(u32x4*)(tdst + ((size_t)n * tK + 8 * c) * 2) = o; }
    }
    LDS_FENCE();
}

__device__ __forceinline__ void row_to_bf16_ss(const float* xrow, bf16_t* orow, float* ssp, int lane) {
    const f32x4* xr = (const f32x4*)xrow + lane;
    f32x4 v[8]; float s = 0.f;
#pragma unroll
    for (int j = 0; j < 8; ++j) { v[j] = xr[64 * j]; s += (v[j].x * v[j].x + v[j].y * v[j].y) + (v[j].z * v[j].z + v[j].w * v[j].w); }
    s = wave_sum(s);
    u32x2* o8 = (u32x2*)orow + lane;
#pragma unroll
    for (int j = 0; j < 8; ++j) { u32x2 w; w.x = pk2(v[j].x, v[j].y); w.y = pk2(v[j].z, v[j].w); o8[64 * j] = w; }
    if (lane < 32) ssp[lane] = lane == 0 ? s : 0.f;
}
__device__ __forceinline__ void rms_row_final(const bf16_t* hrow, float* orow, const float* gain, const float* ssrow, int lane) {
    const float rs = pg8::rs_of(ssrow);
#pragma unroll
    for (int j = 0; j < 4; ++j) { const u32x4 b = *((const u32x4*)hrow + lane + 64 * j);
        const f32x4 g0 = *((const f32x4*)gain + 2 * (lane + 64 * j)), g1 = *((const f32x4*)gain + 2 * (lane + 64 * j) + 1);
        *((f32x4*)orow + 2 * (lane + 64 * j)) = (f32x4){bflo(b.x), bfhi(b.x), bflo(b.y), bfhi(b.y)} * rs * g0;
        *((f32x4*)orow + 2 * (lane + 64 * j) + 1) = (f32x4){bflo(b.z), bfhi(b.z), bflo(b.w), bfhi(b.w)} * rs * g1; }
}

template <int NT>
__device__ __forceinline__ void rms_rows_final(const bf16_t* HBp, float* outp, const f32x4 (&g)[8], const float* ssb, int m0, int mstep, int lane) {
    u32x4 b[NT][4]; f32x4 sv[NT][8];
#pragma unroll
    for (int t = 0; t < NT; ++t) { const size_t m = (size_t)(m0 + t * mstep);
#pragma unroll
        for (int j = 0; j < 4; ++j) b[t][j] = *((const u32x4*)(HBp + m * D_MODEL) + lane + 64 * j);
#pragma unroll
        for (int i = 0; i < 8; ++i) sv[t][i] = ((const f32x4*)(ssb + m * 32))[i]; }
#pragma unroll
    for (int t = 0; t < NT; ++t) { float s = 0.f;
#pragma unroll
        for (int i = 0; i < 8; ++i) s += (sv[t][i][0] + sv[t][i][1]) + (sv[t][i][2] + sv[t][i][3]);
        const float rs = 1.0f / sqrtf(s * (1.0f / 2048.0f) + 1e-6f);
        float* orow = outp + (size_t)(m0 + t * mstep) * D_MODEL;
#pragma unroll
        for (int j = 0; j < 4; ++j) { const u32x4 x = b[t][j];
            *((f32x4*)orow + 2 * (lane + 64 * j)) = (f32x4){bflo(x.x), bfhi(x.x), bflo(x.y), bfhi(x.y)} * rs * g[2 * j];
            *((f32x4*)orow + 2 * (lane + 64 * j) + 1) = (f32x4){bflo(x.z), bfhi(x.z), bflo(x.w), bfhi(x.w)} * rs * g[2 * j + 1]; } }
}

__device__ __forceinline__ void prologue(Frame& F) {
    LAS float* scr = (LAS float*)(F.lds + F.wave * 16384);
    const int gw = F.c * 8 + F.wave, NGW = F.G * 8;
    for (int L = 0; L < DEPTH; ++L) {
        unsigned char* wl = F.ws + WS_W + (size_t)L * WL_SIZE;
        const float* w_in = F.in[2] + (size_t)L * D_MODEL * IN_COLS;
        const float* g_attn = F.in[1] + (size_t)L * D_MODEL;
        constexpr int I_WIN = 32 * (PN / 32), I_WINV = 32 * (VTN / 32), I_UQ = 6 * 24, I_UKV = 4 * 16, I_OUT = 32 * 64, I_UP = 32 * 256, I_DN = 128 * 64, I_W1 = 32 * 2;
        constexpr int NITEMS = I_WIN + I_WINV + I_UQ + 2 * I_UKV + I_OUT + I_UP + I_DN + 2 * I_W1;
#define PRO_LOAD(T, it_) do { int r = (it_); int lane_ = F.lane; asm volatile("" : "+v"(lane_)); \
            if (r < I_WIN) { titem_load(T##v, T##sc, T##dst, T##K, T##fp8, w_in, D_MODEL, IN_COLS, wl + WL_WIN, D_MODEL, g_attn, map_win_rm, r, PN / 32, lane_, false); break; } r -= I_WIN; \
            if (r < I_WINV) { titem_load(T##v, T##sc, T##dst, T##K, T##fp8, w_in, D_MODEL, IN_COLS, wl + WL_WINV, D_MODEL, g_attn, map_win_v, r, VTN / 32, lane_, false); break; } r -= I_WINV; \
            if (r < I_UQ) { titem_load(T##v, T##sc, T##dst, T##K, T##fp8, F.in[4] + (size_t)L * 384 * 768, 384, 768, wl + WL_WUQ, 384, F.in[3] + L * 384, map_uq, r, 24, lane_, false); break; } r -= I_UQ; \
            if (r < I_UKV) { titem_load(T##v, T##sc, T##dst, T##K, T##fp8, F.in[6] + (size_t)L * 128 * 1024, 128, 1024, wl + WL_WUKVK, 256, F.in[5] + L * 128, map_ukv_k, r, 16, lane_, false); break; } r -= I_UKV; \
            if (r < I_UKV) { titem_load(T##v, T##sc, T##dst, T##K, T##fp8, F.in[6] + (size_t)L * 128 * 1024, 128, 1024, wl + WL_WUKVV, 256, F.in[5] + L * 128, map_ukv_v, r, 16, lane_, false); break; } r -= I_UKV; \
            if (r < I_OUT) { titem_load(T##v, T##sc, T##dst, T##K, T##fp8, F.in[13] + (size_t)L * D_MODEL * D_MODEL, D_MODEL, D_MODEL, wl + WL_WOUT, D_MODEL, F.in[12] + L * D_MODEL, map_id, r, 64, lane_, true); break; } r -= I_OUT; \
            if (r < I_UP) { titem_load(T##v, T##sc, T##dst, T##K, T##fp8, F.in[15] + (size_t)L * D_MODEL * D_FF, D_MODEL, D_FF, wl + WL_WUP, D_MODEL, F.in[14] + L * D_MODEL, map_id, r, 256, lane_, false); break; } r -= I_UP; \
            if (r < I_DN) { titem_load(T##v, T##sc, T##dst, T##K, T##fp8, F.in[16] + (size_t)L * D_FF * D_MODEL, D_FF, D_MODEL, wl + WL_WDN, D_FF, nullptr, map_id, r, 64, lane_, true); break; } r -= I_DN; \
            { const int kv = r / I_W1; r -= kv * I_W1; \
              titem_load(T##v, T##sc, T##dst, T##K, T##fp8, F.in[9] + ((size_t)L * 2 + kv) * 2048 * 64, 2048, 64, (bf16_t*)(wl + WL_W1T) + (size_t)kv * 64 * 2048, 2048, nullptr, map_id, r, 2, lane_, false); } } while (0)
        for (int it = gw; it < NITEMS; it += 2 * NGW) {
            f32x4 tav[8], tbv[8]; float tasc[8], tbsc[8]; unsigned char* tadst; unsigned char* tbdst = nullptr; int taK, tbK = 0; bool tafp8, tbfp8 = false; const bool hb = it + NGW < NITEMS;
            PRO_LOAD(ta, it);
            if (hb) PRO_LOAD(tb, it + NGW);
            titem_finish(tav, tasc, tadst, taK, tafp8, scr, F.lane);
            if (hb) titem_finish(tbv, tbsc, tbdst, tbK, tbfp8, scr, F.lane);
        }
#undef PRO_LOAD
        for (int it = gw; it < 128; it += NGW) { const int kv = it >> 6, n = it & 63;
            const float* pos = F.in[8] + ((size_t)L * 2 + kv) * 2048; const float* w1 = F.in[9] + ((size_t)L * 2 + kv) * 2048 * 64;
            float s = 0.f;
            for (int k = F.lane; k < 2048; k += 64) s += pos[k] * w1[(size_t)k * 64 + n];
            s = wave_sum(s);
            if (F.lane == 0) ((float*)(wl + WL_CB1))[it] = s; }
    }
    bf16_t* HB = (bf16_t*)(F.ws + WS_HB); float* ss0 = (float*)(F.ws + WS_SS);
    for (int m = gw; m < MTOK; m += NGW) row_to_bf16_ss(F.in[0] + (size_t)m * D_MODEL, HB + (size_t)m * D_MODEL, ss0 + (size_t)m * 32, F.lane);
}

__device__ __forceinline__ float rope_inv(int i) { return exp2f(-(float)i * (13.287712379549449f / 16.0f)); }

__device__ __forceinline__ void rope_sincos(int pos, int i, float& sn, float& cs) {
    const float ang = (float)pos * rope_inv(i);
    const double rev = (double)ang * 0.15915494309189535; const float fr = (float)(rev - floor(rev));
    sn = __builtin_amdgcn_sinf(fr); cs = __builtin_amdgcn_cosf(fr);
}
__device__ __forceinline__ void krope_tokens(const bf16_t* P, bf16_t* KR, int tok0, int lane) {
    const int tok = tok0 + (lane >> 4), i = lane & 15;
    const bf16_t* prow = P + (size_t)tok * PN + PC_KR;
    const float x1 = bf2f(prow[i]), x2 = bf2f(prow[16 + i]);
    float sn, cs; rope_sincos(tok & (SEQ - 1), i, sn, cs);
    KR[(size_t)tok * 32 + i] = (bf16_t)f2bf(x1 * cs - x2 * sn); KR[(size_t)tok * 32 + 16 + i] = (bf16_t)f2bf(x1 * sn + x2 * cs);
}

__device__ __forceinline__ void fox_scan_seq(Frame& F, const bf16_t* P, const float* bf, float* fc, int seq) {
    const int b = seq >> 3, h = seq & 7; const float bias = bf[h];
    LAS float* sc = (LAS float*)(F.lds);
    const int t0 = F.tid * 16; float v[16]; float run = 0.f;
#pragma unroll
    for (int i = 0; i < 16; ++i) { const float x = bf2f(P[(size_t)(b * SEQ + t0 + i) * PN + PC_FF + h]) + bias;
        const float ls = fminf(x, 0.f) - log1pf(expf(-fabsf(x))); run += ls * LOG2E; v[i] = run; }
    float incl = run;
#pragma unroll
    for (int o = 1; o < 64; o <<= 1) { const float n = __builtin_bit_cast(float, __builtin_amdgcn_ds_bpermute(((F.lane - o) & 63) << 2, __builtin_bit_cast(int, incl))); if (F.lane >= o) incl += n; }
    if (F.lane == 63) sc[F.wave] = incl;
    __syncthreads();
    float woff = 0.f;
    for (int w = 0; w < F.wave; ++w) woff += sc[w];
    const float excl = woff + incl - run;
    float* o = fc + (size_t)seq * SEQ + t0;
#pragma unroll
    for (int i = 0; i < 16; i += 4) *(f32x4*)(o + i) = (f32x4){v[i] + excl, v[i + 1] + excl, v[i + 2] + excl, v[i + 3] + excl};
    __syncthreads();
}

__device__ __forceinline__ void fox_norm_tile(const bf16_t* P, float* kt, float* qt, int item, int lane) {
    const int t = item & 127, bh = item >> 7, b = bh >> 3, h = bh & 7;
    const bf16_t* row = P + (size_t)(b * SEQ + 64 * t + lane) * PN + h * 64;
    float sk = 0.f, sq = 0.f;
#pragma unroll
    for (int c = 0; c < 8; ++c) { const u32x4 kk = *(const u32x4*)(row + PC_FK + 8 * c), qq = *(const u32x4*)(row + PC_FQ + 8 * c);
        sk += (bflo(kk.x) * bflo(kk.x) + bfhi(kk.x) * bfhi(kk.x)) + (bflo(kk.y) * bflo(kk.y) + bfhi(kk.y) * bfhi(kk.y)) + (bflo(kk.z) * bflo(kk.z) + bfhi(kk.z) * bfhi(kk.z)) + (bflo(kk.w) * bflo(kk.w) + bfhi(kk.w) * bfhi(kk.w));
        sq += (bflo(qq.x) * bflo(qq.x) + bfhi(qq.x) * bfhi(qq.x)) + (bflo(qq.y) * bflo(qq.y) + bfhi(qq.y) * bfhi(qq.y)) + (bflo(qq.z) * bflo(qq.z) + bfhi(qq.z) * bfhi(qq.z)) + (bflo(qq.w) * bflo(qq.w) + bfhi(qq.w) * bfhi(qq.w)); }
    sk = wave_max(sk); sq = wave_max(sq);
    if (lane == 0) { kt[item] = sqrtf(sk); qt[item] = sqrtf(sq); }
}

__device__ __forceinline__ float gelu_tanh(float x) { const float u = 0.7978845608028654f * (x + 0.044715f * x * x * x); return 0.5f * x * (1.f + tanhf(u)); }
__device__ __forceinline__ void nsa_compress_item(Frame& F, int item, const bf16_t* P, const bf16_t* w1t, const float* cb1, const float* w2, bf16_t* kcmp, bf16_t* vcmpt) {
    const int ct = item & 15, g = (item >> 4) & 1, kv = (item >> 5) & 1, b = item >> 6;
    const int lane = F.lane, r32 = lane & 31, hi = lane >> 5;
    const int c = ct * 32 + r32, cl = c > 510 ? 510 : c;
    const bf16_t* arow = P + (size_t)(b * SEQ + 16 * cl) * PN + (kv ? PC_VC : PC_KC) + g * 64 + 8 * hi;
    const bf16_t* w1k = w1t + (size_t)kv * 64 * 2048;
    f32x16 acc0, acc1;
#pragma unroll
    for (int i = 0; i < 16; ++i) { acc0[i] = 0.f; acc1[i] = 0.f; }
#pragma unroll
    for (int li = 0; li < 4; ++li) { const int l = F.wave * 4 + li;
#pragma unroll
        for (int s = 0; s < 4; ++s) {
            const bf16x8 a = *(const bf16x8*)(arow + (size_t)l * PN + 16 * s);
            const bf16x8 b0 = *(const bf16x8*)(w1k + (size_t)r32 * 2048 + l * 64 + 16 * s + 8 * hi);
            const bf16x8 b1 = *(const bf16x8*)(w1k + (size_t)(32 + r32) * 2048 + l * 64 + 16 * s + 8 * hi);
            acc0 = __builtin_amdgcn_mfma_f32_32x32x16_bf16(a, b0, acc0, 0, 0, 0);
            acc1 = __builtin_amdgcn_mfma_f32_32x32x16_bf16(a, b1, acc1, 0, 0, 0); } }
    LAS float* red = (LAS float*)(F.lds);
    LAS float* hid = (LAS float*)(F.lds + 65536);
#pragma unroll
    for (int r = 0; r < 16; ++r) { const int cc = (r & 3) + 8 * (r >> 2) + 4 * hi;
        red[(F.wave * 32 + cc) * 64 + r32] = acc0[r]; red[(F.wave * 32 + cc) * 64 + 32 + r32] = acc1[r]; }
    __syncthreads();
#pragma unroll
    for (int i = 0; i < 4; ++i) { const int idx = F.tid + 512 * i, cc = idx >> 6, n = idx & 63;
        float s = cb1[kv * 64 + n];
#pragma unroll
        for (int w = 0; w < 8; ++w) s += red[(w * 32 + cc) * 64 + n];
        hid[cc * 65 + n] = gelu_tanh(s); }
    __syncthreads();
    const float* w2k = w2 + (size_t)kv * 64 * 64;
    float w2r[64];
#pragma unroll
    for (int n = 0; n < 64; ++n) w2r[n] = w2k[n * 64 + (F.tid & 63)];
#pragma unroll
    for (int i = 0; i < 4; ++i) { const int idx = F.tid + 512 * i, cc = idx >> 6, n2 = idx & 63;
        float s = 0.f;
#pragma unroll
        for (int n = 0; n < 64; ++n) s += hid[cc * 65 + n] * w2r[n];
        const int co = ct * 32 + cc; if (co > 510) s = 0.f;
        if (kv == 0) kcmp[((size_t)(b * 2 + g) * 512 + co) * 64 + n2] = (bf16_t)f2bf(s);
        else vcmpt[((size_t)(b * 2 + g) * 64 + n2) * 512 + co] = (bf16_t)f2bf(s); }
    __syncthreads();
}

template <int NT>
__device__ __forceinline__ void combine_norm_tokens(const bf16_t* O, unsigned char* O8, const bf16_t* P, const bf16_t* OC, const bf16_t* OS, const bf16_t* OW, int m0, int mstep, int lane) {
    u32x4 v[NT][4], pa[NT], pb[NT], pc[NT]; float g[NT][3];
    const int head = lane >> 3;
#pragma unroll
    for (int t = 0; t < NT; ++t) { const size_t m = (size_t)(m0 + t * mstep); const bf16_t* orow = O + m * D_MODEL; const bf16_t* prow = P + m * PN;
        v[t][0] = *(const u32x4*)(orow + 8 * lane); v[t][1] = *(const u32x4*)(orow + 512 + 8 * lane); v[t][3] = *(const u32x4*)(orow + 1536 + 8 * lane);
        pa[t] = *(const u32x4*)(OC + m * 512 + 8 * lane); pb[t] = *(const u32x4*)(OS + m * 512 + 8 * lane); pc[t] = *(const u32x4*)(OW + m * 512 + 8 * lane);
#pragma unroll
        for (int i = 0; i < 3; ++i) g[t][i] = bf2f(prow[PC_GATE + head * 3 + i]); }
    float f[NT][4][8], ss[NT][4];
#pragma unroll
    for (int t = 0; t < NT; ++t) {
        const float g0 = 1.f / (1.f + expf(-g[t][0])), g1 = 1.f / (1.f + expf(-g[t][1])), g2 = 1.f / (1.f + expf(-g[t][2]));
#pragma unroll
        for (int grp = 0; grp < 4; ++grp) {
            if (grp != 2) { const u32x4 x = v[t][grp];
                f[t][grp][0] = bflo(x.x); f[t][grp][1] = bfhi(x.x); f[t][grp][2] = bflo(x.y); f[t][grp][3] = bfhi(x.y); f[t][grp][4] = bflo(x.z); f[t][grp][5] = bfhi(x.z); f[t][grp][6] = bflo(x.w); f[t][grp][7] = bfhi(x.w);
            } else { const u32x4 a = pa[t], bq = pb[t], cq = pc[t];
                f[t][2][0] = g0 * bflo(a.x) + g1 * bflo(bq.x) + g2 * bflo(cq.x); f[t][2][1] = g0 * bfhi(a.x) + g1 * bfhi(bq.x) + g2 * bfhi(cq.x);
                f[t][2][2] = g0 * bflo(a.y) + g1 * bflo(bq.y) + g2 * bflo(cq.y); f[t][2][3] = g0 * bfhi(a.y) + g1 * bfhi(bq.y) + g2 * bfhi(cq.y);
                f[t][2][4] = g0 * bflo(a.z) + g1 * bflo(bq.z) + g2 * bflo(cq.z); f[t][2][5] = g0 * bfhi(a.z) + g1 * bfhi(bq.z) + g2 * bfhi(cq.z);
                f[t][2][6] = g0 * bflo(a.w) + g1 * bflo(bq.w) + g2 * bflo(cq.w); f[t][2][7] = g0 * bfhi(a.w) + g1 * bfhi(bq.w) + g2 * bfhi(cq.w); }
            float s = 0.f;
#pragma unroll
            for (int i = 0; i < 8; ++i) s += f[t][grp][i] * f[t][grp][i];
            ss[t][grp] = s; } }
#pragma unroll
    for (int t = 0; t < NT; ++t)
#pragma unroll
        for (int grp = 0; grp < 4; ++grp) ss[t][grp] = wave_sum(ss[t][grp]);
#pragma unroll
    for (int t = 0; t < NT; ++t) { unsigned char* orow = O8 + (size_t)(m0 + t * mstep) * D_MODEL;
#pragma unroll
        for (int grp = 0; grp < 4; ++grp) { const float rs = 1.0f / sqrtf(ss[t][grp] * (1.f / 512.f) + EPS); const float* ff = f[t][grp];
            int w0 = 0, w1 = 0;
            w0 = __builtin_amdgcn_cvt_pk_fp8_f32(ff[0] * rs, ff[1] * rs, w0, false); w0 = __builtin_amdgcn_cvt_pk_fp8_f32(ff[2] * rs, ff[3] * rs, w0, true);
            w1 = __builtin_amdgcn_cvt_pk_fp8_f32(ff[4] * rs, ff[5] * rs, w1, false); w1 = __builtin_amdgcn_cvt_pk_fp8_f32(ff[6] * rs, ff[7] * rs, w1, true);
            *(u32x2*)(orow + grp * 512 + 8 * lane) = (u32x2){(unsigned)w0, (unsigned)w1}; } }
}

__device__ __forceinline__ int crow(int r, int hi) { return (r & 3) + 8 * (r >> 2) + 4 * hi; }
template <int NS, int KSTR>
__device__ __forceinline__ void qk_tile(LAS unsigned char* lds, const bf16x8* qf, f32x16& p0, f32x16& p1, int r32, int hi) {
    const LAS unsigned char* kb = lds + A_K + r32 * KSTR + 16 * hi;
#pragma unroll
    for (int s = 0; s < NS; ++s) {
        const bf16x8 a0 = *(const LAS bf16x8*)(kb + 32 * s), a1 = *(const LAS bf16x8*)(kb + 32 * KSTR + 32 * s);
        p0 = __builtin_amdgcn_mfma_f32_32x32x16_bf16(a0, qf[s], p0, 0, 0, 0);
        p1 = __builtin_amdgcn_mfma_f32_32x32x16_bf16(a1, qf[s], p1, 0, 0, 0); }
}
__device__ __forceinline__ bf16x8 pack8(const f32x16& p, int base) {
    u32x4 w; w.x = pk2(p[base + 0], p[base + 1]); w.y = pk2(p[base + 2], p[base + 3]); w.z = pk2(p[base + 4], p[base + 5]); w.w = pk2(p[base + 6], p[base + 7]);
    return __builtin_bit_cast(bf16x8, w);
}
__device__ __forceinline__ void pv_tile(LAS unsigned char* lds, const f32x16& p0, const f32x16& p1, f32x16& o0, f32x16& o1, int r32, int hi) {
    const LAS unsigned char* vb = lds + A_V + r32 * A_VSTR + 8 * hi;
#pragma unroll
    for (int s = 0; s < 4; ++s) {
        const bf16x8 pb = (s < 2) ? pack8(p0, 8 * s) : pack8(p1, 8 * (s - 2));
        const s16x4 a0l = *(const LAS s16x4*)(vb + 32 * s), a0h = *(const LAS s16x4*)(vb + 32 * s + 16);
        const s16x4 a1l = *(const LAS s16x4*)(vb + 32 * A_VSTR + 32 * s), a1h = *(const LAS s16x4*)(vb + 32 * A_VSTR + 32 * s + 16);
        const bf16x8 va0 = (bf16x8){a0l[0], a0l[1], a0l[2], a0l[3], a0h[0], a0h[1], a0h[2], a0h[3]};
        const bf16x8 va1 = (bf16x8){a1l[0], a1l[1], a1l[2], a1l[3], a1h[0], a1h[1], a1h[2], a1h[3]};
        o0 = __builtin_amdgcn_mfma_f32_32x32x16_bf16(va0, pb, o0, 0, 0, 0);
        o1 = __builtin_amdgcn_mfma_f32_32x32x16_bf16(va1, pb, o1, 0, 0, 0); }
}
__device__ __forceinline__ void store_o(bf16_t* orow, const f32x16& o0, const f32x16& o1, float inv, int hi) {
#pragma unroll
    for (int g = 0; g < 4; ++g) {
        u32x2 w0, w1; w0.x = pk2(o0[4 * g] * inv, o0[4 * g + 1] * inv); w0.y = pk2(o0[4 * g + 2] * inv, o0[4 * g + 3] * inv);
        w1.x = pk2(o1[4 * g] * inv, o1[4 * g + 1] * inv); w1.y = pk2(o1[4 * g + 2] * inv, o1[4 * g + 3] * inv);
        *(u32x2*)(orow + 8 * g + 4 * hi) = w0; *(u32x2*)(orow + 32 + 8 * g + 4 * hi) = w1; }
}
__device__ __forceinline__ void mla_tile_split(const LAS unsigned char* klds, const LAS unsigned char* vlds, const bf16x8* qf, float& m, float& l, f32x16& o0, f32x16& o1, int r32, int hi) {
    const LAS unsigned char* kb = klds + A_K + r32 * A_KSTR96 + 16 * hi;
    const LAS unsigned char* vb = vlds + A_V + r32 * A_VSTR + 8 * hi;
    const float nm = -m;
    f32x16 p0, p1;
#pragma unroll
    for (int i = 0; i < 16; ++i) { p0[i] = nm; p1[i] = nm; }
#pragma unroll
    for (int s = 0; s < 6; ++s) p0 = __builtin_amdgcn_mfma_f32_32x32x16_bf16(*(const LAS bf16x8*)(kb + 32 * s), qf[s], p0, 0, 0, 0);
#pragma unroll
    for (int s = 0; s < 6; ++s) p1 = __builtin_amdgcn_mfma_f32_32x32x16_bf16(*(const LAS bf16x8*)(kb + 32 * A_KSTR96 + 32 * s), qf[s], p1, 0, 0, 0);
    float rs = 0.f;
#pragma unroll
    for (int r = 0; r < 16; ++r) { p0[r] = fexp2(p0[r]); rs += p0[r]; }
#pragma unroll
    for (int s = 0; s < 2; ++s) { const bf16x8 pb = pack8(p0, 8 * s);
        const s16x4 a0l = *(const LAS s16x4*)(vb + 32 * s), a0h = *(const LAS s16x4*)(vb + 32 * s + 16);
        const s16x4 a1l = *(const LAS s16x4*)(vb + 32 * A_VSTR + 32 * s), a1h = *(const LAS s16x4*)(vb + 32 * A_VSTR + 32 * s + 16);
        o0 = __builtin_amdgcn_mfma_f32_32x32x16_bf16((bf16x8){a0l[0], a0l[1], a0l[2], a0l[3], a0h[0], a0h[1], a0h[2], a0h[3]}, pb, o0, 0, 0, 0);
        o1 = __builtin_amdgcn_mfma_f32_32x32x16_bf16((bf16x8){a1l[0], a1l[1], a1l[2], a1l[3], a1h[0], a1h[1], a1h[2], a1h[3]}, pb, o1, 0, 0, 0); }
#pragma unroll
    for (int r = 0; r < 16; ++r) { p1[r] = fexp2(p1[r]); rs += p1[r]; }
#pragma unroll
    for (int s = 2; s < 4; ++s) { const bf16x8 pb = pack8(p1, 8 * (s - 2));
        const s16x4 a0l = *(const LAS s16x4*)(vb + 32 * s), a0h = *(const LAS s16x4*)(vb + 32 * s + 16);
        const s16x4 a1l = *(const LAS s16x4*)(vb + 32 * A_VSTR + 32 * s), a1h = *(const LAS s16x4*)(vb + 32 * A_VSTR + 32 * s + 16);
        o0 = __builtin_amdgcn_mfma_f32_32x32x16_bf16((bf16x8){a0l[0], a0l[1], a0l[2], a0l[3], a0h[0], a0h[1], a0h[2], a0h[3]}, pb, o0, 0, 0, 0);
        o1 = __builtin_amdgcn_mfma_f32_32x32x16_bf16((bf16x8){a1l[0], a1l[1], a1l[2], a1l[3], a1h[0], a1h[1], a1h[2], a1h[3]}, pb, o1, 0, 0, 0); }
    l += rs;
    if (__any(rs > 4096.0f)) { const float rt = sum_x32(rs), dm = fmaxf(__log2f(rt), 0.f), alpha = fexp2(-dm); m += dm; l *= alpha;
#pragma unroll
        for (int r = 0; r < 16; ++r) { o0[r] *= alpha; o1[r] *= alpha; } }
}
__device__ __forceinline__ float max3f(float a, float b, float c) { float r; asm("v_max3_f32 %0, %1, %2, %3" : "=v"(r) : "v"(a), "v"(b), "v"(c)); return r; }
__device__ __forceinline__ float max32(const f32x16& p0, const f32x16& p1) {
    float a = max3f(p0[0], p0[1], p1[0]), b = max3f(p0[2], p0[3], p1[1]); a = max3f(a, p1[2], p1[3]);
#pragma unroll
    for (int r = 4; r < 16; r += 4) { a = max3f(a, p0[r], p0[r + 1]); b = max3f(b, p0[r + 2], p0[r + 3]); a = max3f(a, p1[r], p1[r + 1]); b = max3f(b, p1[r + 2], p1[r + 3]); }
    a = fmaxf(a, b);
    float x0 = a, x1 = a;
    asm volatile("s_nop 1\n\tv_permlane32_swap_b32 %0, %1" : "+v"(x0), "+v"(x1));
    return fmaxf(x0, x1);
}
__device__ __forceinline__ int t5_bucket(int d) {
    if (d < 16) return d;
    const int v = 16 + (int)(logf((float)d * (1.f / 16.f)) * (16.0f / 2.0794415416798357f));
    return v < 31 ? v : 31;
}
__device__ __forceinline__ void load_bias_table(Frame& F, const float* rel_bias, int hoff) {
    LAS float* tb = (LAS float*)(F.lds + A_TB);
    for (int e = F.tid; e < 8 * 129; e += 512) { const int h = e / 129, i = e % 129; tb[h * A_TBSTR + i] = rel_bias[t5_bucket(i) * 16 + hoff + h] * LOG2E; }
    __syncthreads();
}

struct AttnArgs {
    const bf16_t* Q; int qpitch, qcol;
    const bf16_t* K; int kpitch, kcol;
    const bf16_t* Kr;
    const bf16_t* VT;
    const float* fc;
    bf16_t* O; int opitch, ocol;
    const float* sinks;
    const float* kt; const float* qt;
};
template <int MODE>
__device__ __forceinline__ void attn_unit(Frame& F, const AttnArgs& a, int b, int hg, int qb) {
    constexpr bool DENSE = MODE < 2;
    constexpr int DK = MODE == 0 ? 96 : 64, NS = DK / 16, KSTR = MODE == 0 ? A_KSTR96 : A_KSTR64, W = MODE == 2 ? 256 : (MODE == 3 ? 128 : (1 << 30));
    LAS unsigned char* lds = F.lds;
    const int tid = F.tid, lane = F.lane, wid = F.wave, r32 = lane & 31, hi = lane >> 5;
    const int q0 = DENSE ? qb * 256 : qb * 64, qw0 = DENSE ? q0 + 32 * wid : q0 + 8 * wid, qw1 = DENSE ? qw0 + 31 : qw0 + 7;
    const int q = DENSE ? qw0 + r32 : qw0 + (r32 & 7), head = DENSE ? hg : 4 * hg + (r32 >> 3);
    int t_lo = (DENSE || MODE == 4) ? 0 : ((q0 - W + 1) > 0 ? (q0 - W + 1) >> 6 : 0); const int t_hi = DENSE ? 4 * qb + 3 : qb;
    if constexpr (MODE == 1) {
        float km = 0.f;
        if (lane <= t_hi) km = a.kt[lane];
        if (lane + 64 <= t_hi) km = fmaxf(km, a.kt[lane + 64]);
        km = wave_max(km);
        const float qm = fmaxf(fmaxf(a.qt[4 * qb], a.qt[4 * qb + 1]), fmaxf(a.qt[4 * qb + 2], a.qt[4 * qb + 3]));
        const float thr = -(48.0f + 2.02f * qm * km), f0 = a.fc[q0];
        const int n_int = 4 * qb;
        const bool s0 = lane < n_int && (f0 - a.fc[64 * lane + 63]) < thr, s1 = lane + 64 < n_int && (f0 - a.fc[64 * (lane + 64) + 63]) < thr;
        t_lo = __popcll(__ballot(s0)) + __popcll(__ballot(s1));
    }
    const LAS unsigned* selm = (const LAS unsigned*)(lds + A_SEL) + (wid * 8 + (r32 & 7)) * 4;
    bf16x8 qf[NS];
    { const bf16_t* qp = a.Q + (size_t)(b * SEQ + q) * a.qpitch + a.qcol + head * DK + 8 * hi;
#pragma unroll
      for (int s = 0; s < NS; ++s) qf[s] = *(const bf16x8*)(qp + 16 * s); }
    if constexpr (MODE == 0) {
        bf16x8 x1 = qf[4], x2 = qf[5];
#pragma unroll
        for (int j = 0; j < 8; ++j) { float sn, cs; rope_sincos(q, 8 * hi + j, sn, cs);
            const float u = bf2f((unsigned short)x1[j]), v = bf2f((unsigned short)x2[j]);
            x1[j] = (short)f2bf(u * cs - v * sn); x2[j] = (short)f2bf(u * sn + v * cs); }
        qf[4] = x1; qf[5] = x2; }
    const int srow = tid >> 3, sch = tid & 7;
    const bf16_t* kp = a.K + (size_t)(b * SEQ + srow) * a.kpitch + a.kcol + 8 * sch;
    const bf16_t* krp = (MODE == 0) ? a.Kr + (size_t)(b * SEQ + (tid >> 2)) * 32 + 8 * (tid & 3) : nullptr;
    const bf16_t* vp = a.VT + (size_t)srow * MTOK + b * SEQ + 8 * sch;
    constexpr int U_K = 0, U_KS = 64 * A_KSTR96, U_V = 2 * U_KS, U_VS = 64 * A_VSTR, U_FK = U_V + 2 * U_VS;
    LAS unsigned char* kd = lds + U_K + srow * KSTR + 16 * sch;
    LAS unsigned char* krd = lds + U_K + (tid >> 2) * KSTR + 128 + 16 * (tid & 3);
    LAS unsigned char* vd = lds + U_V + srow * A_VSTR + 16 * sch;
    u32x4 rkA, rkrA = (u32x4){0u, 0u, 0u, 0u}, rvA, rkB, rkrB = (u32x4){0u, 0u, 0u, 0u}, rvB; float rfA = 0.f, rfB = 0.f;
#define TT(t) (MODE == 1 ? (t_lo + t_hi - (t)) : (t))
#define ATT_LOAD(R, t) do { const int tl_ = TT(t); rk##R = *(const u32x4*)(kp + (size_t)tl_ * 64 * a.kpitch); rv##R = *(const u32x4*)(vp + tl_ * 64); \
        if (MODE == 0) { if (tid < 256) rkr##R = *(const u32x4*)(krp + (size_t)tl_ * 64 * 32); } \
        if (MODE == 1) { if (tid < 64) rf##R = a.fc[tl_ * 64 + tid]; } } while (0)
#define ATT_WRITE(R, S) do { *(LAS u32x4*)(kd + (S) * U_KS) = rk##R; *(LAS u32x2*)(vd + (S) * U_VS) = (u32x2){rv##R.x, rv##R.y}; *(LAS u32x2*)(vd + (S) * U_VS + 8) = (u32x2){rv##R.z, rv##R.w}; \
        if (MODE == 0) { if (tid < 256) *(LAS u32x4*)(krd + (S) * U_KS) = rkr##R; } \
        if (MODE == 1) { if (tid < 64) ((LAS float*)(lds + U_FK + (S) * 256))[tid] = rf##R; } } while (0)
    f32x16 o0, o1;
#pragma unroll
    for (int i = 0; i < 16; ++i) { o0[i] = 0.f; o1[i] = 0.f; }
    float m = NEGF, l = 0.f;
    if constexpr (MODE == 3) { m = a.sinks[head] * LOG2E; l = hi == 0 ? 1.f : 0.f; }
#define ATT_COMPUTE(tt, S) do { const int t_ = TT(tt); const int kv0 = 64 * t_; \
        bool selbit = true; \
        if constexpr (MODE == 4) selbit = ((selm[t_ >> 5] >> (t_ & 31)) & 1u) != 0u; \
        const bool active = DENSE ? (kv0 <= qw1) : (MODE == 4 ? (__any(selbit) != 0) : (kv0 <= qw1 && kv0 + 63 >= qw0 - W + 1)); \
        if (MODE == 0 && active && kv0 + 63 <= qw0 && !__any(m == NEGF)) { \
            mla_tile_split(lds + U_K + (S) * U_KS - A_K, lds + U_V + (S) * U_VS - A_V, qf, m, l, o0, o1, r32, hi); \
        } else if (active) { \
            f32x16 p0, p1; const float nm = (m == NEGF) ? 0.f : -m;     \
            if constexpr (MODE == 1) { \
                const LAS float* fk = (const LAS float*)(lds + U_FK + (S) * 256); \
                _Pragma("unroll") for (int g = 0; g < 4; ++g) { const f32x4 x0 = *(const LAS f32x4*)(fk + 8 * g + 4 * hi), x1 = *(const LAS f32x4*)(fk + 32 + 8 * g + 4 * hi); \
                    _Pragma("unroll") for (int i = 0; i < 4; ++i) { p0[4 * g + i] = nm - x0[i]; p1[4 * g + i] = nm - x1[i]; } } \
            } else { \
                _Pragma("unroll") for (int i = 0; i < 16; ++i) { p0[i] = nm; p1[i] = nm; } \
            } \
            qk_tile<NS, KSTR>(lds + U_K + (S) * U_KS - A_K, qf, p0, p1, r32, hi); \
            if constexpr (DENSE) { \
                if (kv0 + 63 > qw0) { \
                    _Pragma("unroll") for (int r = 0; r < 16; ++r) { const int kv = kv0 + crow(r, hi); if (kv > q) p0[r] = NEGF; if (kv + 32 > q) p1[r] = NEGF; } } \
            } else { \
                const LAS float* tb = (const LAS float*)(lds + A_TB) + (head & 7) * A_TBSTR; \
                _Pragma("unroll") for (int r = 0; r < 16; ++r) { const int d0 = q - (kv0 + crow(r, hi)), d1 = d0 - 32; \
                    const int i0 = d0 < 0 ? 0 : (d0 > 128 ? 128 : d0), i1 = d1 < 0 ? 0 : (d1 > 128 ? 128 : d1); \
                    p0[r] = (d0 >= 0 && d0 < W && selbit) ? p0[r] + tb[i0] : NEGF; p1[r] = (d1 >= 0 && d1 < W && selbit) ? p1[r] + tb[i1] : NEGF; } \
            } \
              \
            const bool expfirst = MODE != 1 && !__any(m == NEGF); \
            bool keep = true; \
            if (!expfirst) { \
                const float mx = max32(p0, p1);                  \
                const bool unset = (m == NEGF), seen = mx > -1e29f; \
                  \
                if (MODE == 1) keep = __any(unset || mx > -38.0f); \
                if (keep && __any(unset ? seen : (mx > 8.0f))) { const float dm = unset ? (seen ? mx : 0.f) : fmaxf(mx, 0.f), alpha = unset ? 1.f : fexp2(-dm); m = unset ? (seen ? mx : NEGF) : m + dm; l *= alpha; \
                    _Pragma("unroll") for (int r = 0; r < 16; ++r) { o0[r] *= alpha; o1[r] *= alpha; p0[r] -= dm; p1[r] -= dm; } } \
            } \
            if (keep) { \
                float rs = 0.f; \
                _Pragma("unroll") for (int r = 0; r < 16; ++r) { p0[r] = fexp2(p0[r]); p1[r] = fexp2(p1[r]); rs += p0[r] + p1[r]; } \
                if (expfirst && __any(rs > 4096.0f)) { const float dm = fmaxf(__log2f(max32(p0, p1)), 0.f), alpha = fexp2(-dm); m += dm; l *= alpha; rs *= alpha; \
                    _Pragma("unroll") for (int r = 0; r < 16; ++r) { o0[r] *= alpha; o1[r] *= alpha; p0[r] *= alpha; p1[r] *= alpha; } } \
                l += rs; \
                pv_tile(lds + U_V + (S) * U_VS - A_V, p0, p1, o0, o1, r32, hi); } \
        } } while (0)
    ATT_LOAD(A, t_lo);
    if (t_lo < t_hi) ATT_LOAD(B, t_lo + 1);
    __syncthreads();
    ATT_WRITE(A, 0);
    if (t_lo + 2 <= t_hi) ATT_LOAD(A, t_lo + 2);
    __syncthreads();
    for (int t = t_lo; ; t += 2) {
        if (t + 1 <= t_hi) { ATT_WRITE(B, 1); if (t + 3 <= t_hi) ATT_LOAD(B, t + 3); }
        ATT_COMPUTE(t, 0);
        if (t + 1 > t_hi) break;
        __syncthreads();
        if (t + 2 <= t_hi) { ATT_WRITE(A, 0); if (t + 4 <= t_hi) ATT_LOAD(A, t + 4); }
        ATT_COMPUTE(t + 1, 1);
        if (t + 2 > t_hi) break;
        __syncthreads();
    }
    const float lt = sum_x32(l), inv = 1.0f / lt;
    store_o(a.O + (size_t)(b * SEQ + q) * a.opitch + a.ocol + head * 64, o0, o1, inv, hi);
    __syncthreads();
#undef ATT_COMPUTE
#undef TT
#undef ATT_LOAD
#undef ATT_WRITE
}

__device__ __forceinline__ void nsa_unit(Frame& F, int b, int g, int qblk, const bf16_t* P, const bf16_t* kcmp, const bf16_t* vcmpt, const bf16_t* VTsel, bf16_t* OC, bf16_t* OS) {
    LAS unsigned char* lds = F.lds;
    const int tid = F.tid, lane = F.lane, wid = F.wave, r32 = lane & 31, hi = lane >> 5;
    const int q0 = qblk * 64, qw0 = q0 + 8 * wid, q = qw0 + (r32 >> 2), rr = r32 & 3, head = 4 * g + rr, cur = qblk;
    const int ntile = (((q0 + 32) >> 4) >> 6) + 1;
    const bf16_t* kc = kcmp + (size_t)(b * 2 + g) * 512 * 64; const bf16_t* vct = vcmpt + (size_t)(b * 2 + g) * 64 * 512;
    bf16x8 qf[4];
    { const bf16_t* qp = P + (size_t)(b * SEQ + q) * PN + PC_NQ + head * 64 + 8 * hi;
#pragma unroll
      for (int s = 0; s < 4; ++s) qf[s] = *(const bf16x8*)(qp + 16 * s); }
    const int srow = tid >> 3, sch = tid & 7;
    const bf16_t* kp = kc + (size_t)srow * 64 + 8 * sch; const bf16_t* vp = vct + (size_t)srow * 512 + 8 * sch;
    LAS unsigned char* kd = lds + N_K0 + srow * A_KSTR64 + 16 * sch; LAS unsigned char* vd = lds + N_V0 + srow * A_VSTR + 16 * sch;
    const LAS float* tb = (const LAS float*)(lds + A_TB) + head * A_TBSTR;
    u32x4 rk, rv;
    LAS float* impG = (LAS float*)(lds + A_IMP + wid * 8192); LAS float* impE = impG + 1024;
    for (int rep5 = 0; rep5 < DUPN(5); ++rep5) {
    float m = 0.f, l = 0.f;
    rk = *(const u32x4*)kp;
    __syncthreads();
    *(LAS u32x4*)kd = rk;
    if (1 < ntile) rk = *(const u32x4*)(kp + (size_t)64 * 64);
    __syncthreads();
    for (int t = 0; t < ntile; ++t) {
        if (t + 1 < ntile) { *(LAS u32x4*)(kd + ((t + 1) & 1) * N_KS) = rk; if (t + 2 < ntile) rk = *(const u32x4*)(kp + (size_t)(t + 2) * 64 * 64); }
        if (1024 * t + 24 <= qw0) {
            const bool far = 1024 * t + 1039 + 128 <= qw0;
            const float ini = far ? tb[128] - m : -m;
            f32x16 p0, p1;
#pragma unroll
            for (int i = 0; i < 16; ++i) { p0[i] = ini; p1[i] = ini; }
            qk_tile<4, A_KSTR64>(lds + N_K0 + (t & 1) * N_KS - A_K, qf, p0, p1, r32, hi);
            if (!far) {
#pragma unroll
            for (int r = 0; r < 16; ++r) { const int d0 = q - (16 * (64 * t + crow(r, hi)) + 31), d1 = d0 - 512;
                const int i0 = d0 < 0 ? 0 : (d0 > 128 ? 128 : d0), i1 = d1 < 0 ? 0 : (d1 > 128 ? 128 : d1);
                p0[r] = d0 >= 0 ? p0[r] + tb[i0] : NEGF; p1[r] = d1 >= 0 ? p1[r] + tb[i1] : NEGF; }
            }
            float rs = 0.f;
#pragma unroll
            for (int r = 0; r < 16; ++r) { p0[r] = fexp2(p0[r]); p1[r] = fexp2(p1[r]); rs += p0[r] + p1[r]; }
            if (__any(rs > 4096.0f)) { const float dm = fmaxf(__log2f(max32(p0, p1)), 0.f), alpha = fexp2(-dm); m += dm; l *= alpha; rs *= alpha; }
            l += rs;
        }
        __syncthreads();
    }
    const float nml = -m - __log2f(sum_x32(l));
    f32x16 o0, o1;
#pragma unroll
    for (int i = 0; i < 16; ++i) { o0[i] = 0.f; o1[i] = 0.f; }
    rk = *(const u32x4*)kp; rv = *(const u32x4*)vp;
    *(LAS u32x4*)kd = rk; *(LAS u32x2*)vd = (u32x2){rv.x, rv.y}; *(LAS u32x2*)(vd + 8) = (u32x2){rv.z, rv.w};
    if (1 < ntile) { rk = *(const u32x4*)(kp + (size_t)64 * 64); rv = *(const u32x4*)(vp + 64); }
    __syncthreads();
    for (int t = 0; t < ntile; ++t) {
        if (t + 1 < ntile) { const int s1 = (t + 1) & 1; *(LAS u32x4*)(kd + s1 * N_KS) = rk; *(LAS u32x2*)(vd + s1 * N_VS) = (u32x2){rv.x, rv.y}; *(LAS u32x2*)(vd + s1 * N_VS + 8) = (u32x2){rv.z, rv.w};
            if (t + 2 < ntile) { rk = *(const u32x4*)(kp + (size_t)(t + 2) * 64 * 64); rv = *(const u32x4*)(vp + (t + 2) * 64); } }
        if (1024 * t + 24 <= qw0) {
            const bool far = 1024 * t + 1039 + 128 <= qw0;
            const float ini = far ? tb[128] + nml : nml;
            f32x16 p0, p1;
#pragma unroll
            for (int i = 0; i < 16; ++i) { p0[i] = ini; p1[i] = ini; }
            qk_tile<4, A_KSTR64>(lds + N_K0 + (t & 1) * N_KS - A_K, qf, p0, p1, r32, hi);
            if (far) {
#pragma unroll
                for (int r = 0; r < 16; ++r) { p0[r] = fexp2(p0[r]); p1[r] = fexp2(p1[r]); }
            } else {
#pragma unroll
            for (int r = 0; r < 16; ++r) { const int d0 = q - (16 * (64 * t + crow(r, hi)) + 31), d1 = d0 - 512;
                const int i0 = d0 < 0 ? 0 : (d0 > 128 ? 128 : d0), i1 = d1 < 0 ? 0 : (d1 > 128 ? 128 : d1);
                p0[r] = d0 >= 0 ? fexp2(p0[r] + tb[i0]) : 0.f; p1[r] = d1 >= 0 ? fexp2(p1[r] + tb[i1]) : 0.f; }
            }
            float gs[8], es[8];
#pragma unroll
            for (int g4 = 0; g4 < 4; ++g4) { gs[g4] = (p0[4 * g4] + p0[4 * g4 + 1]) + (p0[4 * g4 + 2] + p0[4 * g4 + 3]); es[g4] = p0[4 * g4 + 3];
                gs[4 + g4] = (p1[4 * g4] + p1[4 * g4 + 1]) + (p1[4 * g4 + 2] + p1[4 * g4 + 3]); es[4 + g4] = p1[4 * g4 + 3]; }
#pragma unroll
            for (int i = 0; i < 8; ++i) { gs[i] += dpp_f<0xB1>(gs[i]); gs[i] += dpp_f<0x4E>(gs[i]); es[i] += dpp_f<0xB1>(es[i]); es[i] += dpp_f<0x4E>(es[i]); }
            if (rr == 0) { const int qs = r32 >> 2;
#pragma unroll
                for (int g4 = 0; g4 < 4; ++g4) { const int s0 = 16 * t + 2 * g4 + hi;
                    impG[qs * 128 + s0] = gs[g4]; impG[qs * 128 + s0 + 8] = gs[4 + g4]; impE[qs * 128 + s0] = es[g4]; impE[qs * 128 + s0 + 8] = es[4 + g4]; } }
            pv_tile(lds + N_V0 + (t & 1) * N_VS - A_V, p0, p1, o0, o1, r32, hi);
        }
        __syncthreads();
    }
    store_o(OC + (size_t)(b * SEQ + q) * 512 + head * 64, o0, o1, 1.0f, hi);
    }
    LDS_FENCE();
    LAS unsigned* selmw = (LAS unsigned*)(lds + A_SEL) + wid * 32;
#pragma unroll 1
    for (int bq = 0; bq < 2; ++bq) {
        const int qi = 4 * bq + (lane >> 4), l16 = lane & 15;
        const LAS float* G = impG + qi * 128; const LAS float* E = impE + qi * 128;
        const int chi = cur - 2;
        float v[8];
#pragma unroll
        for (int k = 0; k < 8; ++k) { const int s = l16 + 16 * k; v[k] = (s >= 1 && s <= chi) ? G[s] + E[s - 1] : -1.f; }
        unsigned mw[4] = {1u, 0u, 0u, 0u};
#define SETBIT(j) do { const int _j = (j); const unsigned _b = 1u << (_j & 31); const int _w = _j >> 5; mw[0] |= _w == 0 ? _b : 0u; mw[1] |= _w == 1 ? _b : 0u; mw[2] |= _w == 2 ? _b : 0u; mw[3] |= _w == 3 ? _b : 0u; } while (0)
        SETBIT(cur); if (cur >= 1) SETBIT(cur - 1);
#pragma unroll 1
        for (int rnd = 0; rnd < 5; ++rnd) {
            float bv = v[0]; int bi = l16;
#pragma unroll
            for (int k = 1; k < 8; ++k) { if (v[k] > bv) { bv = v[k]; bi = l16 + 16 * k; } }
#define TOPK_STEP(CTRL) do { const float ov = dpp_f<CTRL>(bv); const int oi = dpp_i<CTRL>(bi); if (ov > bv || (ov == bv && oi < bi)) { bv = ov; bi = oi; } } while (0)
            TOPK_STEP(0x128); TOPK_STEP(0x124); TOPK_STEP(0x122); TOPK_STEP(0x121);
#undef TOPK_STEP
            if (bv >= 0.f) SETBIT(bi);
#pragma unroll
            for (int k = 0; k < 8; ++k) { if (bi == l16 + 16 * k) v[k] = -1.f; }
        }
#undef SETBIT
        if (l16 == 0) { selmw[qi * 4 + 0] = mw[0]; selmw[qi * 4 + 1] = mw[1]; selmw[qi * 4 + 2] = mw[2]; selmw[qi * 4 + 3] = mw[3]; }
    }
    LDS_FENCE();
    __syncthreads();
    for (int rep4 = 0; rep4 < DUPN(4); ++rep4) {
        LAS unsigned* wmw = (LAS unsigned*)(lds + A_WM) + wid * 4;
        if (lane < 4) { unsigned x = 0u;
#pragma unroll
            for (int qi = 0; qi < 8; ++qi) x |= selmw[qi * 4 + lane];
            wmw[lane] = x; }
        LDS_FENCE();
        const LAS unsigned* selm = (const LAS unsigned*)selmw + (r32 >> 2) * 4;
        LAS unsigned char* kw = lds + wid * SW_BYTES; LAS unsigned char* vw = kw + 64 * A_KSTR64;
        const LAS float* tbh = (const LAS float*)(lds + A_TB) + head * A_TBSTR;
        const float bias_far = tbh[128];
        const bf16_t* kg = P + ((size_t)b * SEQ + (lane >> 3)) * PN + PC_KS + g * 64 + 8 * (lane & 7);
        const bf16_t* vg = VTsel + (size_t)(g * 64 + (lane >> 3)) * MTOK + (size_t)b * SEQ + 8 * (lane & 7);
        LAS unsigned char* kdst = kw + (lane >> 3) * A_KSTR64 + 16 * (lane & 7); LAS unsigned char* vdst = vw + (lane >> 3) * A_VSTR + 16 * (lane & 7);
        f32x16 o0, o1;
#pragma unroll
        for (int i = 0; i < 16; ++i) { o0[i] = 0.f; o1[i] = 0.f; }
        float m = 0.f, l = 0.f;
        int w = 0; unsigned cw = __builtin_amdgcn_readfirstlane(wmw[0]);
        int j = __builtin_ctz(cw); cw &= cw - 1u;
        u32x4 rk[8], rv[8];
#define SELW_LOAD(jj) do { _Pragma("unroll") for (int i = 0; i < 8; ++i) { rk[i] = *(const u32x4*)(kg + (size_t)(64 * (jj) + 8 * i) * PN); rv[i] = *(const u32x4*)(vg + (size_t)(8 * i) * MTOK + 64 * (jj)); } } while (0)
        SELW_LOAD(j);
        for (;;) {
#pragma unroll
            for (int i = 0; i < 8; ++i) { *(LAS u32x4*)(kdst + 8 * i * A_KSTR64) = rk[i];
                *(LAS u32x2*)(vdst + 8 * i * A_VSTR) = (u32x2){rv[i].x, rv[i].y}; *(LAS u32x2*)(vdst + 8 * i * A_VSTR + 8) = (u32x2){rv[i].z, rv[i].w}; }
            while (cw == 0u && w < 3) { ++w; cw = __builtin_amdgcn_readfirstlane(wmw[w]); }
            const bool more = cw != 0u; int jn = j;
            if (more) { jn = 32 * w + __builtin_ctz(cw); cw &= cw - 1u; SELW_LOAD(jn); }
            {
                const int kv0 = 64 * j;
                const bool selbit = ((selm[j >> 5] >> (j & 31)) & 1u) != 0u;
                const bool far = kv0 + 63 + 128 <= qw0;
                const float ini = far ? (selbit ? bias_far - m : NEGF) : -m;
                f32x16 p0, p1;
#pragma unroll
                for (int i = 0; i < 16; ++i) { p0[i] = ini; p1[i] = ini; }
                qk_tile<4, A_KSTR64>(kw - A_K, qf, p0, p1, r32, hi);
                if (!far) {
#pragma unroll
                    for (int r = 0; r < 16; ++r) { const int d0 = q - (kv0 + crow(r, hi)), d1 = d0 - 32;
                        const int i0 = d0 < 0 ? 0 : (d0 > 128 ? 128 : d0), i1 = d1 < 0 ? 0 : (d1 > 128 ? 128 : d1);
                        p0[r] = (d0 >= 0 && selbit) ? p0[r] + tbh[i0] : NEGF; p1[r] = (d1 >= 0 && selbit) ? p1[r] + tbh[i1] : NEGF; }
                }
                float rs = 0.f;
#pragma unroll
                for (int r = 0; r < 16; ++r) { p0[r] = fexp2(p0[r]); p1[r] = fexp2(p1[r]); rs += p0[r] + p1[r]; }
                l += rs;
                const bool resc = __any(rs > 4096.0f);
                pv_tile(vw - A_V, p0, p1, o0, o1, r32, hi);
                if (resc) { const float rt = sum_x32(rs), dm = fmaxf(__log2f(rt), 0.f), alpha = fexp2(-dm); m += dm; l *= alpha;
#pragma unroll
                    for (int r = 0; r < 16; ++r) { o0[r] *= alpha; o1[r] *= alpha; } }
            }
            if (!more) break;
            j = jn;
        }
#undef SELW_LOAD
        const float lt = sum_x32(l), inv = 1.0f / lt;
        store_o(OS + (size_t)(b * SEQ + q) * 512 + head * 64, o0, o1, inv, hi);
    }
    __syncthreads();
}

__device__ __forceinline__ int fox_head_of_rank(const float* bf, int rho) {
    float v[8];
#pragma unroll
    for (int i = 0; i < 8; ++i) v[i] = bf[i];
    int res = 0;
#pragma unroll
    for (int h = 0; h < 8; ++h) { int rk = 0;
#pragma unroll
        for (int g = 0; g < 8; ++g) rk += (v[g] < v[h] || (v[g] == v[h] && g < h)) ? 1 : 0;
        if (rk == rho) res = h; }
    return res;
}
__device__ const unsigned char SCHED[3][32][4] = {
    {{0,63,95,127},{31,32,94,126},{30,62,64,125},{29,61,93,96},{1,38,92,124},{6,33,91,123},{28,60,65,102},{27,59,70,97},{2,37,90,122},{5,34,89,121},{26,58,66,101},{25,57,69,98},{3,36,88,120},{4,35,87,119},{24,56,67,100},{23,55,68,99},{22,54,86,118},{21,53,85,117},{20,52,84,116},{19,51,83,115},{18,50,82,114},{17,49,81,113},{16,48,80,112},{15,47,79,111},{14,46,78,110},{13,45,77,109},{12,44,76,108},{11,43,75,107},{10,42,74,106},{9,41,73,105},{8,40,72,104},{7,39,71,103}},
    {{51,49,32,14},{66,60,33,12},{80,52,34,9},{111,55,35,6},{104,67,43,4},{100,88,37,2},{95,94,38,1},{107,79,48,0},{78,69,40,10},{116,64,42,7},{102,73,44,5},{120,103,36,3},{91,41,39,15},{75,53,45,13},{85,50,46,11},{122,54,47,8},{113,83,63,31},{125,81,62,30},{127,82,61,29},{124,84,65,28},{121,90,59,27},{99,98,58,26},{123,109,57,24},{118,96,56,25},{119,92,68,23},{108,89,76,21},{126,110,74,16},{105,101,70,22},{117,115,71,19},{114,93,77,18},{106,87,86,17},{112,97,72,20}},
    {{31,48,79,255},{16,63,255,111},{15,255,95,112},{255,47,80,127},{30,49,78,255},{17,62,255,110},{14,255,94,113},{255,46,81,126},{29,50,77,255},{18,61,255,109},{13,255,93,114},{255,45,82,125},{28,51,76,255},{19,60,255,108},{12,255,92,115},{255,44,83,124},{27,52,255,255},{20,59,255,255},{255,255,91,116},{255,255,84,123},{26,53,255,255},{21,58,255,255},{255,255,90,117},{255,255,85,122},{25,54,255,255},{22,57,255,255},{255,255,89,118},{255,255,86,121},{24,55,255,255},{23,56,255,255},{255,255,88,119},{255,255,87,120}}};
constexpr int MLA_POOL_QB = 12;
constexpr int QW_BASE = 4096;

constexpr int PH_PER_LAYER = 5 + 2 * N_CHUNK, NPHASE = 1 + DEPTH * PH_PER_LAYER + 1;
struct Args { const float* in[19]; float* out; unsigned char* ws; int ph_lo, ph_hi; };

__global__ void __launch_bounds__(512, 2) fwd_kernel(Args args) {
    extern __shared__ __attribute__((aligned(16))) unsigned char lds_raw[];
    Frame F;
    F.lds = (LAS unsigned char*)lds_raw;
    const int wave_s = __builtin_amdgcn_readfirstlane(threadIdx.x >> 6);
    F.tid = threadIdx.x; F.lane = F.tid & 63; F.wave = wave_s;
    F.G = gridDim.x; F.c = blockIdx.x;
#pragma unroll
    for (int i = 0; i < 19; ++i) F.in[i] = args.in[i];
    F.out = args.out; F.ws = args.ws;
    volatile LAS unsigned* misc = (volatile LAS unsigned*)(F.lds + LDSCTL_OFF);
    if (F.tid < 64) misc[F.tid] = 0u;
    __syncthreads();
    const int lo = args.ph_lo, hi = args.ph_hi;
    XcdBarrier bar; bar.bar = (unsigned*)(F.ws + WS_CTL); bar.x = 0; bar.st = misc + 8; bar.w0 = wave_s == 0;
    if (hi - lo > 1) bar = xcd_barrier_post((unsigned*)(F.ws + WS_CTL), misc + 8);
#define IN(k) (lo <= (k) && (k) < hi)
#define REFRESH() do { const int _l = lane_now(); F.lane = _l; F.wave = wave_s; F.tid = (wave_s << 6) | _l; } while (0)
#define SEAM(k) do { if (IN(k) && IN((k) + 1)) { for (int rep13 = 0; rep13 < DUPN(13); ++rep13) xcd_barrier(bar); } } while (0)
    unsigned char* ws = F.ws;
    bf16_t* ACT = (bf16_t*)(ws + WS_ACT); bf16_t* P = (bf16_t*)(ws + WS_P); bf16_t* HID = (bf16_t*)(ws + WS_P); bf16_t* VT = (bf16_t*)(ws + WS_VT);
    bf16_t* MQ = (bf16_t*)(ws + WS_MQ); bf16_t* MK = (bf16_t*)(ws + WS_MK); bf16_t* MVT = (bf16_t*)(ws + WS_MVT);
    bf16_t* OC = (bf16_t*)(ws + WS_OC); bf16_t* OS = (bf16_t*)(ws + WS_OS); bf16_t* OW = (bf16_t*)(ws + WS_OW);
    bf16_t* HB = (bf16_t*)(ws + WS_HB); float* SS = (float*)(ws + WS_SS);
    float* KT = (float*)(ws + WS_KT); bf16_t* KR = (bf16_t*)(ws + WS_KR); float* MSQ = (float*)(ws + WS_MSQ); float* MSKV = (float*)(ws + WS_MSKV);
    float* FC = (float*)(ws + WS_FC); bf16_t* KCMP = (bf16_t*)(ws + WS_KCMP); bf16_t* VCMPT = (bf16_t*)(ws + WS_VCMPT);
    const int gw = F.c * 8 + F.wave, NGW = F.G * 8;
    int pid = 0;
    if (IN(pid)) { for (int rep6 = 0; rep6 < DUPN(6); ++rep6) { REFRESH(); prologue(F); } }
    SEAM(pid); ++pid;
    for (int L = 0; L < DEPTH; ++L) {
        unsigned char* wl = ws + WS_W + (size_t)L * WL_SIZE;
        if (IN(pid)) { REFRESH();
            for (int rep12 = 0; rep12 < DUPN(12); ++rep12) {
            { pg8::Gemm g{HB, (const bf16_t*)(wl + WL_WIN), MTOK, PN, D_MODEL, D_MODEL, D_MODEL}; pg8::StaticOrder S; S.init(MTOK, PN, F.G, F.c);
              pg8::EpiBf16<0, 1, 8, true> E{P, PN, SS + (size_t)(2 * L) * MTOK * 32, 1.0f / 2048.0f, MSQ, MSKV}; pg8::gemm_phase(F.lds, g, S, E, F.tid); }
            REFRESH();
            { pg8::Gemm g{(const bf16_t*)(wl + WL_WINV), HB, VTN, MTOK, D_MODEL, D_MODEL, D_MODEL}; pg8::StaticOrder S; S.init(VTN, MTOK, F.G, F.c);
              pg8::EpiBf16<0, 2> E{VT, MTOK, SS + (size_t)(2 * L) * MTOK * 32, 1.0f / 2048.0f, nullptr, nullptr}; pg8::gemm_phase(F.lds, g, S, E, F.tid); }
            REFRESH(); }
        }
        SEAM(pid); ++pid;
        if (IN(pid)) { REFRESH();
            for (int rep11 = 0; rep11 < DUPN(11); ++rep11) {
            { pg8::Gemm g{P + PC_CQ, (const bf16_t*)(wl + WL_WUQ), MTOK, 768, 384, PN, 384}; pg8::StaticOrder S; S.init(MTOK, 768, F.G, F.c);
              pg8::EpiBf16<0, 1, 2> E{MQ, 768, MSQ, 1.0f / 384.0f, nullptr, nullptr}; pg8::gemm_phase(F.lds, g, S, E, F.tid); }
            REFRESH();
            { pg8::Gemm g{P + PC_CKV, (const bf16_t*)(wl + WL_WUKVK), MTOK, 512, 256, PN, 256}; pg8::StaticOrder S; S.init(MTOK, 512, F.G, F.c);
              pg8::EpiBf16<0, 1, 1> E{MK, 512, MSKV, 1.0f / 128.0f, nullptr, nullptr}; pg8::gemm_phase(F.lds, g, S, E, F.tid); }
            REFRESH();
            { pg8::Gemm g{(const bf16_t*)(wl + WL_WUKVV), P + PC_CKV, 512, MTOK, 256, 256, PN}; pg8::StaticOrder S; S.init(512, MTOK, F.G, F.c);
              pg8::EpiBf16<0, 2, 1> E{MVT, MTOK, MSKV, 1.0f / 128.0f, nullptr, nullptr}; pg8::gemm_phase(F.lds, g, S, E, F.tid); }
            REFRESH(); }
            __syncthreads();
            for (int m = 4 * gw; m < MTOK; m += 4 * NGW) krope_tokens(P, KR, m, F.lane);
            REFRESH();
            for (int rep9 = 0; rep9 < DUPN(9); ++rep9) {
            for (int s = F.c >= F.G / 2 ? F.c - F.G / 2 : F.c + F.G / 2; s < BATCH * 8; s += F.G) fox_scan_seq(F, P, F.in[7] + L * 8, FC, s);
            REFRESH();
            for (int it = F.c; it < 256; it += F.G) nsa_compress_item(F, it, P, (const bf16_t*)(wl + WL_W1T), (const float*)(wl + WL_CB1), F.in[10] + (size_t)L * 2 * 64 * 64, KCMP, VCMPT);
            }
            REFRESH();
            for (int it = gw; it < BATCH * 8 * 128; it += NGW) fox_norm_tile(P, KT, KT + BATCH * 8 * 128, it, F.lane);
            __syncthreads(); REFRESH();
            load_bias_table(F, F.in[17], 8);
            for (int rep = 0; rep < DUPN(3); ++rep)
            for (int i = F.c; i < 1024; i += F.G) { const int bg = i & 7, qb = i >> 3, b = bg >> 1, g = bg & 1;
                AttnArgs a{P, PN, PC_SQ, P, PN, PC_SK + g * 64, nullptr, VT + (size_t)(VR_SV + g * 64) * MTOK, nullptr, ACT, D_MODEL, 1536, F.in[11] + L * 8, nullptr, nullptr};
                attn_unit<3>(F, a, b, g, qb); }
            __syncthreads(); REFRESH();
            load_bias_table(F, F.in[17], 0);
            for (int rep = 0; rep < DUPN(3); ++rep)
            for (int i = F.c; i < 1024; i += F.G) { const int bg = i & 7, qb = i >> 3, b = bg >> 1, g = bg & 1;
                AttnArgs a{P, PN, PC_NQ, P, PN, PC_KW + g * 64, nullptr, VT + (size_t)(VR_WV + g * 64) * MTOK, nullptr, OW, 512, 0, nullptr, nullptr, nullptr};
                attn_unit<2>(F, a, b, g, qb); }
            __syncthreads();
        }
        SEAM(pid); ++pid;
        if (IN(pid)) { REFRESH();
            for (int i = F.c; i < 1024; i += F.G) { const int s = i >> 8, vb = i & 255, x = vb & 7, u = SCHED[0][vb >> 3][s], qb = u & 31, b = u >> 5;
                const int h = fox_head_of_rank(F.in[7] + L * 8, b == 0 ? x : (b == 1 ? 7 - x : (b == 2 ? ((x + 4) & 7) : ((3 - x) & 7))));
                AttnArgs a{P, PN, PC_FQ, P, PN, PC_FK + h * 64, nullptr, VT + (size_t)(VR_FV + h * 64) * MTOK, FC + (size_t)(b * 8 + h) * SEQ, ACT, D_MODEL, 512, nullptr, KT + (size_t)(b * 8 + h) * 128, KT + (size_t)(BATCH * 8 + b * 8 + h) * 128};
                attn_unit<1>(F, a, b, h, qb); }
            __syncthreads(); REFRESH();
            load_bias_table(F, F.in[17], 0);
            for (int i = F.c; i < 1024; i += F.G) { const int s = i >> 8, vb = i & 255, bg = vb & 7, b = bg >> 1, g = bg & 1;
                nsa_unit(F, b, g, SCHED[1][vb >> 3][s], P, KCMP, VCMPT, VT + (size_t)VR_VS * MTOK, OC, OS); }
            __syncthreads(); REFRESH();
            for (int i = F.c; i < 1024; i += F.G) { const int s = i >> 8, vb = i & 255, u = SCHED[2][vb >> 3][s], qb = u & 31, bh = (vb & 7) + 8 * (u >> 5), b = bh >> 3, h = bh & 7;
                if (u == 255) continue;
                AttnArgs a{MQ, 768, 0, MK, 512, h * 64, KR, MVT + (size_t)(h * 64) * MTOK, nullptr, ACT, D_MODEL, 0, nullptr, nullptr, nullptr};
                attn_unit<0>(F, a, b, h, qb); }
            REFRESH();
            { unsigned* ctr = (unsigned*)(F.ws + WS_CTL) + QW_BASE + 64 * L; volatile LAS int* qs = (volatile LAS int*)(F.lds + LDSCTL_OFF + 512);
              for (;;) { __syncthreads(); if (F.tid == 0) *qs = (int)__hip_atomic_fetch_add(ctr, 1u, __ATOMIC_RELAXED, __HIP_MEMORY_SCOPE_AGENT); __syncthreads();
                const int i = __builtin_amdgcn_readfirstlane(*qs); if (i >= 32 * MLA_POOL_QB) break;
                const int qb = MLA_POOL_QB - 1 - (i >> 5), bh = i & 31, b = bh >> 3, h = bh & 7;
                AttnArgs a{MQ, 768, 0, MK, 512, h * 64, KR, MVT + (size_t)(h * 64) * MTOK, nullptr, ACT, D_MODEL, 0, nullptr, nullptr, nullptr};
                attn_unit<0>(F, a, b, h, qb); } }
            __syncthreads();
        }
        SEAM(pid); ++pid;
        if (IN(pid)) { REFRESH();
            for (int m = gw; m < MTOK; m += 2 * NGW) { if (m + NGW < MTOK) combine_norm_tokens<2>(ACT, (unsigned char*)VT, P, OC, OS, OW, m, NGW, F.lane); else combine_norm_tokens<1>(ACT, (unsigned char*)VT, P, OC, OS, OW, m, NGW, F.lane); }
        }
        SEAM(pid); ++pid;
        if (IN(pid)) { REFRESH();
            pg8::Gemm g{VT, (const bf16_t*)(wl + WL_WOUT), MTOK, D_MODEL, D_MODEL / 2, D_MODEL / 2, D_MODEL / 2}; pg8::StaticOrder S; S.init(MTOK, D_MODEL, F.G, F.c);
            pg8::EpiResid E{HB, SS + (size_t)(2 * L + 1) * MTOK * 32, D_MODEL}; pg8::gemm_phase<pg8::EpiResid, pg8::StaticOrder, true, 0x7f7f7f7f, 0x79797979>(F.lds, g, S, E, F.tid);
        }
        SEAM(pid); ++pid;
        for (int ch = 0; ch < N_CHUNK; ++ch) {
            if (IN(pid)) { REFRESH();
                pg8::Gemm g{HB + (size_t)ch * MLP_CHUNK * D_MODEL, (const bf16_t*)(wl + WL_WUP), MLP_CHUNK, D_FF, D_MODEL, D_MODEL, D_MODEL}; pg8::StaticOrder S; S.init(MLP_CHUNK, D_FF, F.G, F.c);
                pg8::EpiFp8Relu2 E{(unsigned char*)HID, D_FF, SS + ((size_t)(2 * L + 1) * MTOK + (size_t)ch * MLP_CHUNK) * 32}; for (int rep7 = 0; rep7 < DUPN(7); ++rep7) { REFRESH(); pg8::gemm_phase(F.lds, g, S, E, F.tid); }
            }
            SEAM(pid); ++pid;
            if (IN(pid)) { REFRESH();
                pg8::Gemm g{HID, (const bf16_t*)(wl + WL_WDN), MLP_CHUNK, D_MODEL, D_FF / 2, D_FF / 2, D_FF / 2}; pg8::StaticOrder S; S.init(MLP_CHUNK, D_MODEL, F.G, F.c);
                pg8::EpiResid E{HB + (size_t)ch * MLP_CHUNK * D_MODEL, SS + ((size_t)(2 * L + 2) * MTOK + (size_t)ch * MLP_CHUNK) * 32, D_MODEL}; pg8::gemm_phase<pg8::EpiResid, pg8::StaticOrder, true, 0x7f7f7f7f, 0x79797979>(F.lds, g, S, E, F.tid);
            }
            SEAM(pid); ++pid;
        }
    }
    if (IN(pid)) { REFRESH();
        { f32x4 g[8];
#pragma unroll
          for (int j = 0; j < 4; ++j) { g[2 * j] = *((const f32x4*)F.in[18] + 2 * (F.lane + 64 * j)); g[2 * j + 1] = *((const f32x4*)F.in[18] + 2 * (F.lane + 64 * j) + 1); }
          const float* ssb = SS + (size_t)(2 * DEPTH) * MTOK * 32;
          for (int m = gw; m < MTOK; m += 2 * NGW) { if (m + NGW < MTOK) rms_rows_final<2>(HB, F.out, g, ssb, m, NGW, F.lane); else rms_rows_final<1>(HB, F.out, g, ssb, m, NGW, F.lane); } }
    }
    ++pid;
#undef IN
#undef SEAM
}

#ifndef MK_ONE_LAUNCH
#define MK_ONE_LAUNCH 1
#endif
extern "C" void kernel_launch(void* const* d_in, const int* in_sizes, int n_in, void* d_out, int out_size, void* d_ws, size_t ws_size, hipStream_t stream) {
    static int grid = 0;
    if (grid == 0) {
        if (n_in != 19 || out_size != MTOK * D_MODEL || ws_size < WS_END) { fprintf(stderr, "kernel_launch: unexpected shapes (n_in %d out %d ws %zu need %zu)\n", n_in, out_size, ws_size, (size_t)WS_END); grid = -1; return; }
        int dev = 0, cus = 0, per_cu = 0;
        if (hipGetDevice(&dev) != hipSuccess || hipDeviceGetAttribute(&cus, hipDeviceAttributeMultiprocessorCount, dev) != hipSuccess) { grid = -1; return; }
        if (hipFuncSetAttribute((const void*)fwd_kernel, hipFuncAttributeMaxDynamicSharedMemorySize, LDS_BYTES) != hipSuccess) { fprintf(stderr, "kernel_launch: hipFuncSetAttribute failed\n"); grid = -1; return; }
        if (hipOccupancyMaxActiveBlocksPerMultiprocessor(&per_cu, (const void*)fwd_kernel, 512, LDS_BYTES) != hipSuccess || per_cu < 1) { fprintf(stderr, "kernel_launch: occupancy query says %d\n", per_cu); }
        (void)hipGetLastError();
        grid = cus;
    }
    if (grid < 0) return;
    (void)hipMemsetAsync((char*)d_ws + WS_CTL, 0, CTL_ZERO_BYTES, stream);
    Args a{};
    for (int i = 0; i < 19; ++i) a.in[i] = (const float*)d_in[i];
    a.out = (float*)d_out; a.ws = (unsigned char*)d_ws;
#if MK_ONE_LAUNCH
    a.ph_lo = 0; a.ph_hi = NPHASE;
    hipLaunchKernelGGL(fwd_kernel, dim3(grid), dim3(512), LDS_BYTES, stream, a);
#else
    for (int p = 0; p < NPHASE; ++p) { a.ph_lo = p; a.ph_hi = p + 1; hipLaunchKernelGGL(fwd_kernel, dim3(grid), dim3(512), LDS_BYTES, stream, a); }
#endif
}
```
